# Optimizing an MI355X kernel written in HIP

```python
import math
import jax, jax.numpy as jnp
from jax import lax
import numpy as np

D_MODEL = 2048
BATCH = 4
SEQ = 4096
DEPTH = 1

D_MIX = D_MODEL
D_POOL = D_MIX // 2
POOL_WINDOWS = (2, 4, 8, 16)
N_POOL_GROUPS = len(POOL_WINDOWS)
POOL_GROUP = D_POOL // N_POOL_GROUPS
D_ATTN = D_MIX - D_POOL
N_HEADS = 8
HEAD_DIM = D_ATTN // N_HEADS
IDX_HEADS = 16
IDX_DIM = 64
INDEXER_SCALE = (IDX_HEADS * IDX_DIM) ** -0.5
MAX_TOPK = 256
Q_BLOCK = 128
N_BUCKETS = 32
MAX_DISTANCE = 128
PEER_HEADS = 8
PEER_KEYS = 128
N_EXPERTS = PEER_KEYS * PEER_KEYS
PEER_QDIM = 256
PEER_HALF = PEER_QDIM // 2
PEER_TOPK = 16
PEER_CHUNK = 128
ALPHA = (2 * DEPTH) ** 0.25
BETA = (8 * DEPTH) ** -0.25
LN_EPS = 1e-5
NEG_INF = -1e30

SPLIT_SIZES = (D_POOL, D_ATTN, D_ATTN, D_ATTN, IDX_HEADS * IDX_DIM, IDX_DIM, IDX_HEADS)
D_IN = sum(SPLIT_SIZES)

kernel_name = "hymba_pool_dsa_peer_deepnorm"


def layer_norm(x, g, b):
    xf = x.astype(jnp.float32)
    mu = jnp.mean(xf, axis=-1, keepdims=True)
    var = jnp.mean(jnp.square(xf - mu), axis=-1, keepdims=True)
    y = (xf - mu) * lax.rsqrt(var + LN_EPS)
    return (y * g.astype(jnp.float32) + b.astype(jnp.float32)).astype(x.dtype)


def split_columns(proj):
    parts, start = [], 0
    for size in SPLIT_SIZES:
        parts.append(proj[..., start:start + size])
        start += size
    return parts


def pool_mixer(v, pool_w, pool_scale):
    B, S, _ = v.shape
    vg = v.reshape(B, S, N_POOL_GROUPS, POOL_GROUP)
    c = jnp.cumsum(vg.astype(jnp.float32), axis=1)
    c = jnp.pad(c, ((0, 0), (1, 0), (0, 0), (0, 0)))
    pos = jnp.arange(S)
    means = []
    for g, w in enumerate(POOL_WINDOWS):
        cg = c[:, :, g]
        hi = cg[:, 1:]
        lo = cg[:, jnp.maximum(pos + 1 - w, 0)]
        cnt = jnp.minimum(pos + 1, w).astype(jnp.float32)[None, :, None]
        means.append((hi - lo) / cnt)
    pooled = jnp.stack(means, axis=2).astype(v.dtype) - vg
    mixed = jnp.einsum('bsgc,gcd->bsgd', pooled, pool_w)
    return mixed.reshape(B, S, D_POOL) * pool_scale


def t5_bucket(dist):
    max_exact = N_BUCKETS // 2
    d = jnp.maximum(dist, 1).astype(jnp.float32)
    large = max_exact + (jnp.log(d / max_exact) / math.log(MAX_DISTANCE / max_exact)
                         * (N_BUCKETS - max_exact)).astype(jnp.int32)
    large = jnp.minimum(large, N_BUCKETS - 1)
    return jnp.where(dist < max_exact, dist, large)


def sparse_attention(q, k, v, q_idx, k_idx, w_idx, rel_bias):
    B, S = q.shape[:2]
    top_k = min(MAX_TOPK, S // 4)
    n_blocks = S // Q_BLOCK
    b_ix = jnp.arange(B)[:, None, None]
    key_pos = jnp.arange(S)

    def block(i):
        start = i * Q_BLOCK
        qi = lax.dynamic_slice_in_dim(q_idx, start, Q_BLOCK, axis=1)
        wi = lax.dynamic_slice_in_dim(w_idx, start, Q_BLOCK, axis=1)
        qa = lax.dynamic_slice_in_dim(q, start, Q_BLOCK, axis=1)
        q_pos = start + jnp.arange(Q_BLOCK)
        rel = jax.nn.relu(jnp.einsum('bqhd,bsd->bqhs', qi, k_idx))
        score = jnp.einsum('bqh,bqhs->bqs', wi, rel).astype(jnp.float32) * INDEXER_SCALE
        causal = key_pos[None, :] <= q_pos[:, None]
        score = jnp.where(causal[None], score, NEG_INF)
        _, sel = lax.top_k(score, top_k)
        k_sel = k[b_ix, sel]
        v_sel = v[b_ix, sel]
        logits = jnp.einsum('bqhd,bqkhd->bhqk', qa, k_sel).astype(jnp.float32) * HEAD_DIM ** -0.5
        dist = q_pos[None, :, None] - sel
        bias = rel_bias[t5_bucket(jnp.maximum(dist, 0))]
        logits = logits + jnp.transpose(bias, (0, 3, 1, 2)).astype(jnp.float32)
        logits = jnp.where((dist >= 0)[:, None], logits, NEG_INF)
        p = jax.nn.softmax(logits, axis=-1).astype(v.dtype)
        return jnp.einsum('bhqk,bqkhd->bqhd', p, v_sel)

    out = lax.map(block, jnp.arange(n_blocks))
    return jnp.transpose(out, (1, 0, 2, 3, 4)).reshape(B, S, N_HEADS * HEAD_DIM)


def peer_ffn(x, wq, sub_keys, u, v):
    B, S, D = x.shape
    xt = x.reshape(-1, PEER_CHUNK, D)

    def chunk(xc):
        qh = (xc @ wq).reshape(PEER_CHUNK, PEER_HEADS, 2, PEER_HALF)
        s1 = jnp.einsum('thd,kd->thk', qh[:, :, 0], sub_keys[0]).astype(jnp.float32)
        s2 = jnp.einsum('thd,kd->thk', qh[:, :, 1], sub_keys[1]).astype(jnp.float32)
        v1, i1 = lax.top_k(s1, PEER_TOPK)
        v2, i2 = lax.top_k(s2, PEER_TOPK)
        cand = (v1[..., :, None] + v2[..., None, :]).reshape(PEER_CHUNK, PEER_HEADS, PEER_TOPK * PEER_TOPK)
        cidx = (i1[..., :, None] * PEER_KEYS + i2[..., None, :]).reshape(PEER_CHUNK, PEER_HEADS, PEER_TOPK * PEER_TOPK)
        best, pos = lax.top_k(cand, PEER_TOPK)
        expert = jnp.take_along_axis(cidx, pos, axis=-1)
        gate = jax.nn.softmax(best, axis=-1)
        u_sel = u[expert]
        v_sel = v[expert]
        act = jax.nn.gelu(jnp.einsum('td,thkd->thk', xc, u_sel).astype(jnp.float32), approximate=False)
        return jnp.einsum('thk,thkd->td', (gate * act).astype(x.dtype), v_sel)

    return lax.map(chunk, xt).reshape(B, S, D)


def setup_inputs(seed: int = 0) -> dict:
    key = jax.random.key(seed)
    ks = jax.random.split(key, 16)
    f32 = jnp.float32
    L = DEPTH
    x = jax.random.normal(ks[0], (BATCH, SEQ, D_MODEL), f32)
    w_in = jax.random.normal(ks[1], (L, D_MODEL, D_IN), f32) * D_MODEL ** -0.5
    pool_w = jax.random.normal(ks[2], (L, N_POOL_GROUPS, POOL_GROUP, POOL_GROUP), f32) * POOL_GROUP ** -0.5
    pool_scale = 1.0 + 0.1 * jax.random.normal(ks[3], (L, D_POOL), f32)
    rel_bias = 0.5 * jax.random.normal(ks[4], (N_BUCKETS, N_HEADS), f32)
    w_out = jax.random.normal(ks[5], (L, D_MIX, D_MODEL), f32) * (D_MIX ** -0.5 * BETA)
    ln1_g = 1.0 + 0.05 * jax.random.normal(ks[6], (L, D_MODEL), f32)
    ln1_b = 0.02 * jax.random.normal(ks[7], (L, D_MODEL), f32)
    peer_wq = jax.random.normal(ks[8], (L, D_MODEL, PEER_HEADS * PEER_QDIM), f32) * D_MODEL ** -0.5
    peer_subkeys = jax.random.normal(ks[9], (L, 2, PEER_KEYS, PEER_HALF), f32) * PEER_HALF ** -0.5
    peer_u = jax.random.normal(ks[10], (L, N_EXPERTS, D_MODEL), f32) * D_MODEL ** -0.5
    peer_v = jax.random.normal(ks[11], (L, N_EXPERTS, D_MODEL), f32) * (BETA * PEER_HEADS ** -0.5)
    ln2_g = 1.0 + 0.05 * jax.random.normal(ks[12], (L, D_MODEL), f32)
    ln2_b = 0.02 * jax.random.normal(ks[13], (L, D_MODEL), f32)
    return {"x": x, "w_in": w_in, "pool_w": pool_w, "pool_scale": pool_scale,
            "rel_bias": rel_bias, "w_out": w_out, "ln1_g": ln1_g, "ln1_b": ln1_b,
            "peer_wq": peer_wq, "peer_subkeys": peer_subkeys, "peer_u": peer_u,
            "peer_v": peer_v, "ln2_g": ln2_g, "ln2_b": ln2_b}


def reference(x, w_in, pool_w, pool_scale, rel_bias, w_out, ln1_g, ln1_b,
              peer_wq, peer_subkeys, peer_u, peer_v, ln2_g, ln2_b):
    B, S, _ = x.shape
    h = x
    for l in range(DEPTH):
        proj = h @ w_in[l]
        p_pool, p_q, p_k, p_v, p_qi, p_ki, p_wi = split_columns(proj)
        out_pool = pool_mixer(p_pool, pool_w[l], pool_scale[l])
        out_attn = sparse_attention(
            p_q.reshape(B, S, N_HEADS, HEAD_DIM),
            p_k.reshape(B, S, N_HEADS, HEAD_DIM),
            p_v.reshape(B, S, N_HEADS, HEAD_DIM),
            p_qi.reshape(B, S, IDX_HEADS, IDX_DIM), p_ki, p_wi, rel_bias)
        mix = jnp.concatenate([out_pool, out_attn], axis=-1) @ w_out[l]
        h = layer_norm(ALPHA * h + mix, ln1_g[l], ln1_b[l])
        ffn = peer_ffn(h, peer_wq[l], peer_subkeys[l], peer_u[l], peer_v[l])
        h = layer_norm(ALPHA * h + ffn, ln2_g[l], ln2_b[l])
    return h
```

```cpp
#include <hip/hip_runtime.h>
#include <cstdint>
#include <cstdio>

constexpr int D_MODEL = 2048, BATCH = 4, SEQ = 4096, M_TOK = BATCH * SEQ;
constexpr int D_POOL = 1024, D_ATTN = 1024, N_HEADS = 8, HEAD_DIM = 128;
constexpr int IDX_HEADS = 16, IDX_DIM = 64, TOPK = 256;
constexpr int D_IN = 5200;
constexpr int PEER_HEADS = 8, PEER_KEYS = 128, PEER_HALF = 128, PEER_TOPK = 16, N_EXPERTS = 16384;
constexpr float ALPHA = 1.189207115002721f;
constexpr float LN_EPS = 1e-5f;
constexpr float LOG2E = 1.4426950408889634f;
constexpr float QSCALE = 0.08838834764831845f * LOG2E;

constexpr size_t MiB = 1ull << 20;
constexpr size_t WS_CTL = 0;
constexpr size_t WS_POOLWT = 1 * MiB, WS_WOUTT = 2 * MiB, WS_WQT = 10 * MiB, WS_WINT = 18 * MiB;
constexpr size_t WS_KIWI = 40 * MiB;
constexpr size_t WS_MASK = 48 * MiB;
constexpr size_t WS_POOLED = 56 * MiB;
constexpr size_t WS_XB = 88 * MiB;
constexpr size_t WS_MIXIN = WS_XB;
constexpr size_t WS_PV = 152 * MiB, WS_Q = 184 * MiB, WS_K = 216 * MiB, WS_V = 248 * MiB, WS_QI = 280 * MiB;
constexpr size_t WS_HB = 152 * MiB;
constexpr size_t WS_QP = 216 * MiB;
constexpr size_t WS_UB = 312 * MiB, WS_VB = 376 * MiB;
constexpr size_t WS_END = 440 * MiB;

typedef unsigned short bf16_t;
typedef float f32x4 __attribute__((ext_vector_type(4)));
typedef unsigned u32x4 __attribute__((ext_vector_type(4)));
typedef unsigned u32x2 __attribute__((ext_vector_type(2)));

__device__ __forceinline__ unsigned f2bf(float f) { unsigned u = __builtin_bit_cast(unsigned, f); return (u + 0x7fffu + ((u >> 16) & 1u)) >> 16; }
__device__ __forceinline__ unsigned pk2(float lo, float hi) { return f2bf(lo) | (f2bf(hi) << 16); }
__device__ __forceinline__ float bf2f(unsigned short b) { return __builtin_bit_cast(float, (unsigned)b << 16); }
__device__ __forceinline__ float bflo(unsigned w) { return __builtin_bit_cast(float, w << 16); }
__device__ __forceinline__ float bfhi(unsigned w) { return __builtin_bit_cast(float, w & 0xffff0000u); }
__device__ __forceinline__ float wave_sum(float v) {
#pragma unroll
    for (int o = 1; o < 64; o <<= 1) v += __shfl_xor(v, o);
    return v;
}
__device__ __forceinline__ float wave_max(float v) {
#pragma unroll
    for (int o = 1; o < 64; o <<= 1) v = fmaxf(v, __shfl_xor(v, o));
    return v;
}
__device__ __forceinline__ int wave_min_i(int v) {
#pragma unroll
    for (int o = 1; o < 64; o <<= 1) v = min(v, __shfl_xor(v, o));
    return v;
}

__global__ void cvt_bf16_kernel(const float* __restrict__ in, bf16_t* __restrict__ out, size_t n8) {
    size_t i = (size_t)blockIdx.x * blockDim.x + threadIdx.x;
    const size_t stride = (size_t)gridDim.x * blockDim.x;
    for (; i < n8; i += stride) {
        const f32x4 a = ((const f32x4*)in)[2 * i], b = ((const f32x4*)in)[2 * i + 1];
        u32x4 w; w.x = pk2(a.x, a.y); w.y = pk2(a.z, a.w); w.z = pk2(b.x, b.y); w.w = pk2(b.z, b.w);
        ((u32x4*)out)[i] = w;
    }
}

struct GemmP {
    const void* A; int lda; const float* B; int ldb; int M, N, K;
    int a_goff, b_goff, c_goff;
    void* o0; void* o1; const float* aux;
};
enum { EPI_PROJ = 0, EPI_POOL = 1, EPI_OUTP = 2, EPI_PEERQ = 3 };

template <int EPI> __device__ __forceinline__ void epi_store(const GemmP& p, int m, int n, float v) {
    if (EPI == EPI_PROJ) {
        if (n < 5120) {
            const int t = n >> 10, c = n & 1023;
            bf16_t* base = (bf16_t*)p.o0 + (size_t)t * ((size_t)M_TOK * 1024);
            if (t == 1) v *= QSCALE;
            base[(size_t)m * 1024 + c] = (bf16_t)f2bf(v);
        } else {
            ((bf16_t*)p.o1)[(size_t)m * 256 + (n - 5120)] = (bf16_t)f2bf(v);
        }
    } else if (EPI == EPI_POOL) {
        ((bf16_t*)p.o0)[(size_t)m * 2048 + n] = (bf16_t)f2bf(v * p.aux[n]);
    } else if (EPI == EPI_OUTP) {
        ((float*)p.o0)[(size_t)m * 2048 + n] = ALPHA * p.aux[(size_t)m * 2048 + n] + v;
    } else {
        ((bf16_t*)p.o0)[(size_t)m * 2048 + n] = (bf16_t)f2bf(v);
    }
}

template <int EPI, bool A_BF16>
__global__ void __launch_bounds__(256) sgemm_naive(GemmP p) {
    __shared__ float As[16][68];
    __shared__ float Bs[16][68];
    const int tid = threadIdx.x, tx = tid & 15, ty = tid >> 4;
    const int m0 = blockIdx.y * 64, n0 = blockIdx.x * 64, g = blockIdx.z;
    const int acol = g * p.a_goff, ccol = g * p.c_goff;
    const float* B = p.B + (size_t)g * p.b_goff;
    float acc[4][4];
#pragma unroll
    for (int i = 0; i < 4; ++i)
#pragma unroll
        for (int j = 0; j < 4; ++j) acc[i][j] = 0.f;
    const int ar = tid >> 2, ak = (tid & 3) * 4;
    const int bk = tid >> 4, bn = (tid & 15) * 4;
    for (int k0 = 0; k0 < p.K; k0 += 16) {
        float a4[4];
        if (A_BF16) {
            const u32x2 w = *(const u32x2*)((const bf16_t*)p.A + (size_t)(m0 + ar) * p.lda + acol + k0 + ak);
            a4[0] = bflo(w.x); a4[1] = bfhi(w.x); a4[2] = bflo(w.y); a4[3] = bfhi(w.y);
        } else {
            const f32x4 w = *(const f32x4*)((const float*)p.A + (size_t)(m0 + ar) * p.lda + acol + k0 + ak);
            a4[0] = w.x; a4[1] = w.y; a4[2] = w.z; a4[3] = w.w;
        }
        f32x4 b4 = (f32x4){0.f, 0.f, 0.f, 0.f};
        if (n0 + bn < p.N) b4 = *(const f32x4*)(B + (size_t)(k0 + bk) * p.ldb + n0 + bn);
        __syncthreads();
#pragma unroll
        for (int i = 0; i < 4; ++i) As[ak + i][ar] = a4[i];
        *(f32x4*)&Bs[bk][bn] = b4;
        __syncthreads();
#pragma unroll
        for (int kk = 0; kk < 16; ++kk) {
            const f32x4 av = *(const f32x4*)&As[kk][ty * 4];
            const f32x4 bv = *(const f32x4*)&Bs[kk][tx * 4];
            const float a_[4] = {av.x, av.y, av.z, av.w}, b_[4] = {bv.x, bv.y, bv.z, bv.w};
#pragma unroll
            for (int i = 0; i < 4; ++i)
#pragma unroll
                for (int j = 0; j < 4; ++j) acc[i][j] = fmaf(a_[i], b_[j], acc[i][j]);
        }
    }
#pragma unroll
    for (int i = 0; i < 4; ++i)
#pragma unroll
        for (int j = 0; j < 4; ++j) {
            const int n = n0 + tx * 4 + j;
            if (n < p.N) epi_store<EPI>(p, m0 + ty * 4 + i, ccol + n, acc[i][j]);
        }
}

__global__ void pool_prep_kernel(const bf16_t* __restrict__ pv, bf16_t* __restrict__ pooled) {
    const size_t i = (size_t)blockIdx.x * blockDim.x + threadIdx.x;
    if (i >= (size_t)M_TOK * D_POOL) return;
    const int c = (int)(i & 1023); const int m = (int)(i >> 10); const int t = m & (SEQ - 1);
    const int w = 2 << (c >> 8);
    const int cnt = min(t + 1, w);
    float s = 0.f;
    for (int j = cnt - 1; j >= 0; --j) s += bf2f(pv[(size_t)(m - j) * 1024 + c]);
    const float mean = s / (float)cnt;
    pooled[i] = (bf16_t)f2bf(mean - bf2f(pv[i]));
}

__device__ __forceinline__ unsigned sortable(float f) { unsigned u = __builtin_bit_cast(unsigned, f); return u ^ ((u >> 31) ? 0xFFFFFFFFu : 0x80000000u); }

__global__ void __launch_bounds__(256) indexer_naive(const bf16_t* __restrict__ qi, const bf16_t* __restrict__ kiwi, unsigned* __restrict__ mask) {
    __shared__ float qs[1024];
    __shared__ float ws[16];
    __shared__ unsigned keys[4096];
    __shared__ unsigned cnt_sh;
    const int m = blockIdx.x, t = m & (SEQ - 1), b0 = m - t, tid = threadIdx.x;
    for (int i = tid; i < 1024; i += 256) qs[i] = bf2f(qi[(size_t)m * 1024 + i]);
    if (tid < 16) ws[tid] = bf2f(kiwi[(size_t)m * 256 + 64 + tid]);
    __syncthreads();
    const int n = t + 1;
    for (int s = tid; s < n; s += 256) {
        const u32x4* kp = (const u32x4*)(kiwi + (size_t)(b0 + s) * 256);
        float kf[64];
#pragma unroll
        for (int i = 0; i < 8; ++i) { const u32x4 w = kp[i];
            kf[8 * i + 0] = bflo(w.x); kf[8 * i + 1] = bfhi(w.x); kf[8 * i + 2] = bflo(w.y); kf[8 * i + 3] = bfhi(w.y);
            kf[8 * i + 4] = bflo(w.z); kf[8 * i + 5] = bfhi(w.z); kf[8 * i + 6] = bflo(w.w); kf[8 * i + 7] = bfhi(w.w); }
        float sc = 0.f;
        for (int h = 0; h < 16; ++h) {
            float d = 0.f;
#pragma unroll
            for (int i = 0; i < 64; ++i) d = fmaf(qs[h * 64 + i], kf[i], d);
            sc = fmaf(ws[h], fmaxf(d, 0.f), sc);
        }
        keys[s] = sortable(sc);
    }
    __syncthreads();
    unsigned tau = 0u; int need_ties = 0; bool all = (n <= TOPK);
    if (!all) {
        unsigned prefix = 0u;
        for (int bit = 31; bit >= 0; --bit) {
            const unsigned cand = prefix | (1u << bit);
            if (tid == 0) cnt_sh = 0u;
            __syncthreads();
            int c = 0;
            for (int s = tid; s < n; s += 256) c += (keys[s] >= cand) ? 1 : 0;
            c = (int)wave_sum((float)c);
            if ((tid & 63) == 0) atomicAdd(&cnt_sh, (unsigned)c);
            __syncthreads();
            if (cnt_sh >= (unsigned)TOPK) prefix = cand;
            __syncthreads();
        }
        tau = prefix;
        if (tid == 0) cnt_sh = 0u;
        __syncthreads();
        int c = 0;
        for (int s = tid; s < n; s += 256) c += (keys[s] > tau) ? 1 : 0;
        c = (int)wave_sum((float)c);
        if ((tid & 63) == 0) atomicAdd(&cnt_sh, (unsigned)c);
        __syncthreads();
        need_ties = TOPK - (int)cnt_sh;
    }
    for (int s0 = 0; s0 < SEQ; s0 += 256) {
        const int s = s0 + tid;
        bool sel = false;
        if (s < n) {
            if (all) sel = true;
            else {
                const unsigned k = keys[s];
                if (k > tau) sel = true;
                else if (k == tau) { int r = 0; for (int s2 = 0; s2 < s; ++s2) r += (keys[s2] == tau) ? 1 : 0; sel = r < need_ties; }
            }
        }
        const unsigned long long bal = __ballot(sel);
        if ((tid & 63) == 0) { const int w = (s0 + tid) >> 5; mask[(size_t)m * 128 + w] = (unsigned)bal; mask[(size_t)m * 128 + w + 1] = (unsigned)(bal >> 32); }
    }
}

__device__ __forceinline__ int t5_bucket(int dist) {
    if (dist < 16) return dist;
    const float d = (float)dist;
    int large = 16 + (int)(logf(d / 16.f) / logf(8.f) * 16.f);
    return large < 31 ? large : 31;
}

__global__ void __launch_bounds__(512) attn_naive(const bf16_t* __restrict__ Q, const bf16_t* __restrict__ K, const bf16_t* __restrict__ V,
                                                   const unsigned* __restrict__ mask, const float* __restrict__ rel_bias, bf16_t* __restrict__ mixin) {
    __shared__ int list[256];
    __shared__ float qsh[8][128];
    __shared__ float bias2[129][8];
    __shared__ int nsel_sh;
    const int m = blockIdx.x, t = m & (SEQ - 1), b0 = m - t, tid = threadIdx.x, lane = tid & 63, wid = tid >> 6;
    for (int i = tid; i < 129 * 8; i += 512) { const int d = i >> 3, h = i & 7; bias2[d][h] = rel_bias[t5_bucket(d) * 8 + h] * LOG2E; }
    qsh[wid][lane] = bf2f(Q[(size_t)m * 1024 + wid * 128 + lane]);
    qsh[wid][lane + 64] = bf2f(Q[(size_t)m * 1024 + wid * 128 + 64 + lane]);
    if (wid == 0) {
        const unsigned w0 = mask[(size_t)m * 128 + 2 * lane], w1 = mask[(size_t)m * 128 + 2 * lane + 1];
        unsigned long long bits = (unsigned long long)w0 | ((unsigned long long)w1 << 32);
        const int c = __popcll(bits);
        int incl = c;
#pragma unroll
        for (int o = 1; o < 64; o <<= 1) { const int v = __shfl_up(incl, o); if (lane >= o) incl += v; }
        int off = incl - c;
        while (bits) { const int pos = __ffsll((long long)bits) - 1; bits &= bits - 1; if (off < 256) list[off] = 64 * lane + pos; ++off; }
        if (lane == 63) nsel_sh = incl < 256 ? incl : 256;
    }
    __syncthreads();
    const int nsel = nsel_sh, h = wid;
    float lg[4]; int sidx[4];
#pragma unroll
    for (int j = 0; j < 4; ++j) {
        const int idx = lane + 64 * j;
        lg[j] = -INFINITY; sidx[j] = 0;
        if (idx < nsel) {
            const int s = list[idx]; sidx[j] = s;
            const u32x4* kp = (const u32x4*)(K + (size_t)(b0 + s) * 1024 + h * 128);
            float d = 0.f;
#pragma unroll
            for (int i = 0; i < 16; ++i) { const u32x4 w = kp[i]; const float* qq = &qsh[h][8 * i];
                d = fmaf(qq[0], bflo(w.x), d); d = fmaf(qq[1], bfhi(w.x), d); d = fmaf(qq[2], bflo(w.y), d); d = fmaf(qq[3], bfhi(w.y), d);
                d = fmaf(qq[4], bflo(w.z), d); d = fmaf(qq[5], bfhi(w.z), d); d = fmaf(qq[6], bflo(w.w), d); d = fmaf(qq[7], bfhi(w.w), d); }
            const int dist = t - s;
            lg[j] = d + bias2[dist < 128 ? dist : 128][h];
        }
    }
    float mx = fmaxf(fmaxf(lg[0], lg[1]), fmaxf(lg[2], lg[3])); mx = wave_max(mx);
    float pr[4], ps = 0.f;
#pragma unroll
    for (int j = 0; j < 4; ++j) { pr[j] = exp2f(lg[j] - mx); ps += pr[j]; }
    ps = wave_sum(ps);
    float o0 = 0.f, o1 = 0.f;
    for (int i = 0; i < nsel; ++i) {
        const int j = i >> 6, src = i & 63;
        float pj = (j == 0) ? pr[0] : (j == 1) ? pr[1] : (j == 2) ? pr[2] : pr[3];
        int sj = (j == 0) ? sidx[0] : (j == 1) ? sidx[1] : (j == 2) ? sidx[2] : sidx[3];
        const float p = __shfl(pj, src); const int s = __shfl(sj, src);
        const unsigned w = *(const unsigned*)(V + (size_t)(b0 + s) * 1024 + h * 128 + 2 * lane);
        o0 = fmaf(p, bflo(w), o0); o1 = fmaf(p, bfhi(w), o1);
    }
    const float inv = 1.f / ps;
    *(unsigned*)(mixin + (size_t)m * 2048 + 1024 + h * 128 + 2 * lane) = pk2(o0 * inv, o1 * inv);
}

__global__ void __launch_bounds__(256) ln1_kernel(float* __restrict__ zh, bf16_t* __restrict__ hb, const float* __restrict__ g, const float* __restrict__ bta) {
    const int lane = threadIdx.x & 63, row = blockIdx.x * 4 + (threadIdx.x >> 6);
    f32x4* zr = (f32x4*)(zh + (size_t)row * 2048) + lane;
    f32x4 v[8]; float s = 0.f;
#pragma unroll
    for (int j = 0; j < 8; ++j) { v[j] = zr[64 * j]; s += (v[j].x + v[j].y) + (v[j].z + v[j].w); }
    const float mean = wave_sum(s) * (1.f / 2048.f); float s2 = 0.f;
#pragma unroll
    for (int j = 0; j < 8; ++j) { v[j] = v[j] - mean; s2 += (v[j].x * v[j].x + v[j].y * v[j].y) + (v[j].z * v[j].z + v[j].w * v[j].w); }
    const float rstd = 1.f / sqrtf(wave_sum(s2) * (1.f / 2048.f) + LN_EPS);
    u32x2* ob = (u32x2*)(hb + (size_t)row * 2048) + lane;
#pragma unroll
    for (int j = 0; j < 8; ++j) {
        const f32x4 gg = ((const f32x4*)g)[lane + 64 * j], bb = ((const f32x4*)bta)[lane + 64 * j];
        const f32x4 o = v[j] * rstd * gg + bb;
        zr[64 * j] = o;
        u32x2 w; w.x = pk2(o.x, o.y); w.y = pk2(o.z, o.w); ob[64 * j] = w;
    }
}

__device__ __forceinline__ float gelu_exact(float x) { return 0.5f * x * (1.f + erff(x * 0.7071067811865476f)); }

template <int NV> __device__ __forceinline__ void wave_top16(float (&val)[NV], int lane, float& outv, int& outi) {
    outv = 0.f; outi = 0;
#pragma unroll 1
    for (int r = 0; r < 16; ++r) {
        float mx = val[0];
#pragma unroll
        for (int j = 1; j < NV; ++j) mx = fmaxf(mx, val[j]);
        mx = wave_max(mx);
        int ci = 0x7fffffff;
#pragma unroll
        for (int j = NV - 1; j >= 0; --j) if (val[j] == mx) ci = lane + 64 * j;
        ci = wave_min_i(ci);
#pragma unroll
        for (int j = 0; j < NV; ++j) if (lane + 64 * j == ci) val[j] = -INFINITY;
        if (lane == r) { outv = mx; outi = ci; }
    }
}

__global__ void __launch_bounds__(512) peer_naive(float* __restrict__ hout, const bf16_t* __restrict__ qp, const float* __restrict__ subkeys,
                                                   const bf16_t* __restrict__ ub, const bf16_t* __restrict__ vb,
                                                   const float* __restrict__ g2, const float* __restrict__ b2) {
    __shared__ float qsh[8][256];
    const int lane = threadIdx.x & 63, wid = threadIdx.x >> 6;
    const int m = blockIdx.x * 8 + wid;
    float hreg[4][8], acc[4][8];
    const float* hrow = hout + (size_t)m * 2048;
#pragma unroll
    for (int c = 0; c < 4; ++c) { const f32x4 a = *(const f32x4*)(hrow + c * 512 + 8 * lane), b = *(const f32x4*)(hrow + c * 512 + 8 * lane + 4);
        hreg[c][0] = a.x; hreg[c][1] = a.y; hreg[c][2] = a.z; hreg[c][3] = a.w; hreg[c][4] = b.x; hreg[c][5] = b.y; hreg[c][6] = b.z; hreg[c][7] = b.w;
#pragma unroll
        for (int i = 0; i < 8; ++i) acc[c][i] = 0.f; }
#pragma unroll 1
    for (int hd = 0; hd < PEER_HEADS; ++hd) {
#pragma unroll
        for (int j = 0; j < 4; ++j) qsh[wid][lane + 64 * j] = bf2f(qp[(size_t)m * 2048 + hd * 256 + lane + 64 * j]);
        __builtin_amdgcn_s_waitcnt(0);
        float s1[2], s2[2];
#pragma unroll
        for (int j = 0; j < 2; ++j) {
            const int k = lane + 64 * j;
            const float* k1 = subkeys + (size_t)k * 128; const float* k2 = subkeys + (size_t)(128 + k) * 128;
            float d1 = 0.f, d2 = 0.f;
#pragma unroll 2
            for (int i = 0; i < 128; i += 4) { const f32x4 a = *(const f32x4*)(k1 + i), b = *(const f32x4*)(k2 + i);
                d1 = fmaf(qsh[wid][i], a.x, d1); d1 = fmaf(qsh[wid][i + 1], a.y, d1); d1 = fmaf(qsh[wid][i + 2], a.z, d1); d1 = fmaf(qsh[wid][i + 3], a.w, d1);
                d2 = fmaf(qsh[wid][128 + i], b.x, d2); d2 = fmaf(qsh[wid][128 + i + 1], b.y, d2); d2 = fmaf(qsh[wid][128 + i + 2], b.z, d2); d2 = fmaf(qsh[wid][128 + i + 3], b.w, d2); }
            s1[j] = d1; s2[j] = d2;
        }
        float v1, v2; int i1, i2;
        wave_top16<2>(s1, lane, v1, i1);
        wave_top16<2>(s2, lane, v2, i2);
        float cand[4]; int cidx[4];
#pragma unroll
        for (int r = 0; r < 4; ++r) { const int c = lane + 64 * r, i = c >> 4, j = c & 15;
            cand[r] = __shfl(v1, i) + __shfl(v2, j); cidx[r] = __shfl(i1, i) * PEER_KEYS + __shfl(i2, j); }
        float bv; int bpos;
        wave_top16<4>(cand, lane, bv, bpos);
        int e_mine;
        { const int r = bpos >> 6, src = bpos & 63;
          const int c0 = __shfl(cidx[0], src), c1 = __shfl(cidx[1], src), c2 = __shfl(cidx[2], src), c3 = __shfl(cidx[3], src);
          e_mine = (r == 0) ? c0 : (r == 1) ? c1 : (r == 2) ? c2 : c3; }
        const float bmax = __shfl(bv, 0);
        float ex = (lane < 16) ? expf(bv - bmax) : 0.f;
        const float esum = wave_sum(ex);
        const float gate_mine = ex / esum;
#pragma unroll 1
        for (int k = 0; k < PEER_TOPK; ++k) {
            const int e = __shfl(e_mine, k); const float gk = __shfl(gate_mine, k);
            const bf16_t* ur = ub + (size_t)e * 2048;
            float d = 0.f;
#pragma unroll
            for (int c = 0; c < 4; ++c) { const u32x4 w = *(const u32x4*)(ur + c * 512 + 8 * lane);
                d = fmaf(hreg[c][0], bflo(w.x), d); d = fmaf(hreg[c][1], bfhi(w.x), d); d = fmaf(hreg[c][2], bflo(w.y), d); d = fmaf(hreg[c][3], bfhi(w.y), d);
                d = fmaf(hreg[c][4], bflo(w.z), d); d = fmaf(hreg[c][5], bfhi(w.z), d); d = fmaf(hreg[c][6], bflo(w.w), d); d = fmaf(hreg[c][7], bfhi(w.w), d); }
            d = wave_sum(d);
            const float gcoef = gk * gelu_exact(d);
            const bf16_t* vr = vb + (size_t)e * 2048;
#pragma unroll
            for (int c = 0; c < 4; ++c) { const u32x4 w = *(const u32x4*)(vr + c * 512 + 8 * lane);
                acc[c][0] = fmaf(gcoef, bflo(w.x), acc[c][0]); acc[c][1] = fmaf(gcoef, bfhi(w.x), acc[c][1]); acc[c][2] = fmaf(gcoef, bflo(w.y), acc[c][2]); acc[c][3] = fmaf(gcoef, bfhi(w.y), acc[c][3]);
                acc[c][4] = fmaf(gcoef, bflo(w.z), acc[c][4]); acc[c][5] = fmaf(gcoef, bfhi(w.z), acc[c][5]); acc[c][6] = fmaf(gcoef, bflo(w.w), acc[c][6]); acc[c][7] = fmaf(gcoef, bfhi(w.w), acc[c][7]); }
        }
    }
    float s = 0.f;
#pragma unroll
    for (int c = 0; c < 4; ++c)
#pragma unroll
        for (int i = 0; i < 8; ++i) { acc[c][i] = fmaf(ALPHA, hreg[c][i], acc[c][i]); s += acc[c][i]; }
    const float mean = wave_sum(s) * (1.f / 2048.f); float s2 = 0.f;
#pragma unroll
    for (int c = 0; c < 4; ++c)
#pragma unroll
        for (int i = 0; i < 8; ++i) { acc[c][i] -= mean; s2 += acc[c][i] * acc[c][i]; }
    const float rstd = 1.f / sqrtf(wave_sum(s2) * (1.f / 2048.f) + LN_EPS);
    float* orow = hout + (size_t)m * 2048;
#pragma unroll
    for (int c = 0; c < 4; ++c) {
        const int e0 = c * 512 + 8 * lane;
        const f32x4 ga = *(const f32x4*)(g2 + e0), gb = *(const f32x4*)(g2 + e0 + 4), ba = *(const f32x4*)(b2 + e0), bb = *(const f32x4*)(b2 + e0 + 4);
        f32x4 oa, ob;
        oa.x = acc[c][0] * rstd * ga.x + ba.x; oa.y = acc[c][1] * rstd * ga.y + ba.y; oa.z = acc[c][2] * rstd * ga.z + ba.z; oa.w = acc[c][3] * rstd * ga.w + ba.w;
        ob.x = acc[c][4] * rstd * gb.x + bb.x; ob.y = acc[c][5] * rstd * gb.y + bb.y; ob.z = acc[c][6] * rstd * gb.z + bb.z; ob.w = acc[c][7] * rstd * gb.w + bb.w;
        *(f32x4*)(orow + e0) = oa; *(f32x4*)(orow + e0 + 4) = ob;
    }
}

extern "C" void kernel_launch(void* const* d_in, const int* in_sizes, int n_in, void* d_out, int out_size, void* d_ws, size_t ws_size, hipStream_t stream) {
    const float* x = (const float*)d_in[0];
    const float* w_in = (const float*)d_in[1];
    const float* pool_w = (const float*)d_in[2];
    const float* pool_scale = (const float*)d_in[3];
    const float* rel_bias = (const float*)d_in[4];
    const float* w_out = (const float*)d_in[5];
    const float* ln1_g = (const float*)d_in[6];
    const float* ln1_b = (const float*)d_in[7];
    const float* peer_wq = (const float*)d_in[8];
    const float* peer_sub = (const float*)d_in[9];
    const float* peer_u = (const float*)d_in[10];
    const float* peer_v = (const float*)d_in[11];
    const float* ln2_g = (const float*)d_in[12];
    const float* ln2_b = (const float*)d_in[13];
    unsigned char* ws = (unsigned char*)d_ws;
    float* out = (float*)d_out;
    if (ws_size < WS_END) { fprintf(stderr, "workspace too small\n"); return; }
    bf16_t* PV = (bf16_t*)(ws + WS_PV); bf16_t* Qb = (bf16_t*)(ws + WS_Q); bf16_t* Kb = (bf16_t*)(ws + WS_K); bf16_t* Vb = (bf16_t*)(ws + WS_V);
    bf16_t* QI = (bf16_t*)(ws + WS_QI); bf16_t* KIWI = (bf16_t*)(ws + WS_KIWI); unsigned* MASK = (unsigned*)(ws + WS_MASK);
    bf16_t* POOLED = (bf16_t*)(ws + WS_POOLED); bf16_t* MIXIN = (bf16_t*)(ws + WS_MIXIN);
    bf16_t* HB = (bf16_t*)(ws + WS_HB); bf16_t* QP = (bf16_t*)(ws + WS_QP); bf16_t* UB = (bf16_t*)(ws + WS_UB); bf16_t* VB = (bf16_t*)(ws + WS_VB);

    cvt_bf16_kernel<<<2048, 256, 0, stream>>>(peer_u, UB, (size_t)N_EXPERTS * 2048 / 8);
    cvt_bf16_kernel<<<2048, 256, 0, stream>>>(peer_v, VB, (size_t)N_EXPERTS * 2048 / 8);
    { GemmP p{}; p.A = x; p.lda = 2048; p.B = w_in; p.ldb = D_IN; p.M = M_TOK; p.N = D_IN; p.K = 2048; p.o0 = PV; p.o1 = KIWI;
      sgemm_naive<EPI_PROJ, false><<<dim3((D_IN + 63) / 64, M_TOK / 64, 1), 256, 0, stream>>>(p); }
    pool_prep_kernel<<<(M_TOK * D_POOL) / 256, 256, 0, stream>>>(PV, POOLED);
    { GemmP p{}; p.A = POOLED; p.lda = 1024; p.B = pool_w; p.ldb = 256; p.M = M_TOK; p.N = 256; p.K = 256; p.a_goff = 256; p.b_goff = 65536; p.c_goff = 256;
      p.o0 = MIXIN; p.aux = pool_scale;
      sgemm_naive<EPI_POOL, true><<<dim3(4, M_TOK / 64, 4), 256, 0, stream>>>(p); }
    indexer_naive<<<M_TOK, 256, 0, stream>>>(QI, KIWI, MASK);
    attn_naive<<<M_TOK, 512, 0, stream>>>(Qb, Kb, Vb, MASK, rel_bias, MIXIN);
    { GemmP p{}; p.A = MIXIN; p.lda = 2048; p.B = w_out; p.ldb = 2048; p.M = M_TOK; p.N = 2048; p.K = 2048; p.o0 = out; p.aux = x;
      sgemm_naive<EPI_OUTP, true><<<dim3(32, M_TOK / 64, 1), 256, 0, stream>>>(p); }
    ln1_kernel<<<M_TOK / 4, 256, 0, stream>>>(out, HB, ln1_g, ln1_b);
    { GemmP p{}; p.A = HB; p.lda = 2048; p.B = peer_wq; p.ldb = 2048; p.M = M_TOK; p.N = 2048; p.K = 2048; p.o0 = QP;
      sgemm_naive<EPI_PEERQ, true><<<dim3(32, M_TOK / 64, 1), 256, 0, stream>>>(p); }
    peer_naive<<<M_TOK / 8, 512, 0, stream>>>(out, QP, peer_sub, UB, VB, ln2_g, ln2_b);
}
```

```cpp
#include <hip/hip_runtime.h>
#include <cstdint>
#include <cstdio>

constexpr int D_MODEL = 2048, BATCH = 4, SEQ = 4096, M_TOK = BATCH * SEQ;
constexpr int D_POOL = 1024, D_ATTN = 1024, N_HEADS = 8, HEAD_DIM = 128;
constexpr int IDX_HEADS = 16, IDX_DIM = 64, TOPK = 256;
constexpr int D_IN = 5200, D_IN_PAD = 5376;
constexpr int PEER_HEADS = 8, PEER_KEYS = 128, PEER_HALF = 128, PEER_TOPK = 16, N_EXPERTS = 16384;
constexpr float ALPHA = 1.189207115002721f;
constexpr float LN_EPS = 1e-5f;
constexpr float LOG2E = 1.4426950408889634f;
constexpr float QSCALE = 0.08838834764831845f * LOG2E;

constexpr size_t MiB = 1ull << 20;
constexpr size_t WS_CTL = 0, CTL_ZERO_BYTES = 768 * 1024;
constexpr size_t WS_CSUM = 192 * 1024, WS_BVEC = 200 * 1024;
constexpr size_t WS_STATSP = 256 * 1024;
constexpr size_t WS_CSP = 392 * MiB, WS_BVP = 392 * MiB + 256 * 1024;
constexpr size_t WS_POOLWT = 1 * MiB, WS_WOUTT = 2 * MiB, WS_WQT = 10 * MiB, WS_WINT = 18 * MiB;
constexpr size_t WS_KIWI = 40 * MiB;
constexpr size_t WS_MASK = 48 * MiB;
constexpr size_t WS_POOLED = 56 * MiB;
constexpr size_t WS_XB = 88 * MiB;
constexpr size_t WS_MIXIN = WS_XB;
constexpr size_t WS_PV = 152 * MiB, WS_Q = 184 * MiB, WS_K = 216 * MiB, WS_V = 248 * MiB, WS_QI = 280 * MiB;
constexpr size_t WS_HB = 152 * MiB;
constexpr size_t WS_QP = 216 * MiB;
constexpr size_t WS_U8 = 312 * MiB, WS_V8 = 344 * MiB;
constexpr size_t WS_EIDX = 376 * MiB, WS_GATE = 384 * MiB;
constexpr size_t WS_ISU = 1 * MiB + 512 * 1024, WS_ISV = WS_ISU + 65536, WS_SKB = WS_ISV + 65536;
constexpr size_t WS_END = 464 * MiB;
constexpr int CW_BAR = 4096;

namespace pg8 {
#define PG8_LAS __attribute__((address_space(3)))
typedef unsigned short bf16_t;
typedef short bf16x8 __attribute__((ext_vector_type(8)));
typedef float f32x4 __attribute__((ext_vector_type(4)));
typedef unsigned u32x4 __attribute__((ext_vector_type(4)));
constexpr int BM = 256, BK = 64, HALF = 128, HTB = HALF * BK * 2  , STAGE_BYTES = 8 * HTB, NXCD = 8, WGM = 8;

__host__ __device__ __forceinline__ int lds_byte(int r, int c) { const int st = (r >> 4) * 2 + (c >> 5), rr = r & 15, cc = c & 31, ob = rr * 64 + cc * 2; return st * 1024 + (ob ^ (((ob >> 9) & 1) << 5)); }
__host__ __device__ __forceinline__ void stage_rc(int b, int& R, int& C) { const int st = b / 1024, sb = b % 1024, swz = sb ^ (((sb >> 9) & 1) << 5); R = (st >> 1) * 16 + swz / 64; C = (st & 1) * 32 + (swz % 64) / 2; }
__host__ __device__ __forceinline__ int perm32(int rho) { const int n = rho >> 4, i = rho & 15; return 8 * (i >> 2) + 4 * n + (i & 3); }

struct Unit { int pm, pn, ord; };
struct Gemm { const bf16_t* A; const bf16_t* Bt; int M, N, K; int lda, ldb; int a_pn_off; int narrow_pn; };

struct StaticOrder {
    int nM, nN, nwg, G, c, ib, ie;
    __host__ __device__ __forceinline__ void init(int M, int N, int G_, int c_) { nM = M / BM; nN = N / BM; nwg = nM * nN; G = G_; c = c_; ib = 0; ie = 1 << 30; }
    __host__ __device__ __forceinline__ bool next(int i, Unit& u) const {
        if (ib + i >= ie) return false;
        const long L = (long)(ib + i) * G + c; if (L >= nwg) return false;
        int wgid = (int)L; { const int q = nwg / NXCD, r = nwg % NXCD, xcd = wgid % NXCD, off = wgid / NXCD; wgid = (xcd < r ? xcd * (q + 1) : r * (q + 1) + (xcd - r) * q) + off; }
        const int nig = WGM * nN, gid = wgid / nig, fm = gid * WGM, gsz = (nM - fm) < WGM ? (nM - fm) : WGM;
        u.pm = fm + ((wgid % nig) % gsz); u.pn = (wgid % nig) / gsz; u.ord = ib + i; return true;
    }
    __device__ __forceinline__ void a_ready(const Unit&) const {}
    __device__ __forceinline__ void done(const Unit&) const {}
};

__device__ __forceinline__ unsigned cvt_pk_bf16(float lo, float hi) { unsigned r; asm volatile("v_cvt_pk_bf16_f32 %0, %1, %2" : "=v"(r) : "v"(lo), "v"(hi)); return r; }

struct EpiProj {
    static constexpr bool PERM = true, AFTER_DRAIN = false;
    bf16_t* O; size_t split_stride; bf16_t* kiwi;
    __device__ __forceinline__ void operator()(const f32x4 (&acc)[2][2][4][2], const Unit& u, int wr, int wc, int fr, int fq) const {
        const int row0 = u.pm * BM + wr * 64 + fr;
        bf16_t* base; int colt, ldc; float sc = 1.f;
        if (u.pn < 20) { const int t = u.pn >> 2; base = O + (size_t)t * split_stride; colt = (u.pn & 3) * BM; ldc = 1024; if (t == 1) sc = QSCALE; }
        else { base = kiwi; colt = 0; ldc = 256; }
        const int col0 = colt + wc * 32 + 8 * fq;
#pragma unroll
        for (int ai = 0; ai < 2; ++ai)
#pragma unroll
            for (int m = 0; m < 4; ++m) { bf16_t* rowp = base + (size_t)(row0 + ai * HALF + m * 16) * ldc + col0;
#pragma unroll
                for (int bj = 0; bj < 2; ++bj) { const f32x4 v0 = acc[ai][bj][m][0] * sc, v1 = acc[ai][bj][m][1] * sc;
                    u32x4 w; w.x = cvt_pk_bf16(v0[0], v0[1]); w.y = cvt_pk_bf16(v0[2], v0[3]); w.z = cvt_pk_bf16(v1[0], v1[1]); w.w = cvt_pk_bf16(v1[2], v1[3]);
                    *(u32x4*)(rowp + bj * HALF) = w; } }
    }
};
struct EpiBf16S {
    static constexpr bool PERM = true, AFTER_DRAIN = false;
    bf16_t* O; int ldc; const float* colscale;
    __device__ __forceinline__ void operator()(const f32x4 (&acc)[2][2][4][2], const Unit& u, int wr, int wc, int fr, int fq) const {
        const int row0 = u.pm * BM + wr * 64 + fr, col0 = u.pn * BM + wc * 32 + 8 * fq;
        f32x4 sv[2][2];
#pragma unroll
        for (int bj = 0; bj < 2; ++bj)
#pragma unroll
            for (int n = 0; n < 2; ++n) sv[bj][n] = colscale ? *(const f32x4*)(colscale + col0 + bj * HALF + 4 * n) : (f32x4){1.f, 1.f, 1.f, 1.f};
#pragma unroll
        for (int ai = 0; ai < 2; ++ai)
#pragma unroll
            for (int m = 0; m < 4; ++m) { bf16_t* rowp = O + (size_t)(row0 + ai * HALF + m * 16) * ldc + col0;
#pragma unroll
                for (int bj = 0; bj < 2; ++bj) { const f32x4 v0 = acc[ai][bj][m][0] * sv[bj][0], v1 = acc[ai][bj][m][1] * sv[bj][1];
                    u32x4 w; w.x = cvt_pk_bf16(v0[0], v0[1]); w.y = cvt_pk_bf16(v0[2], v0[3]); w.z = cvt_pk_bf16(v1[0], v1[1]); w.w = cvt_pk_bf16(v1[2], v1[3]);
                    *(u32x4*)(rowp + bj * HALF) = w; } }
    }
};
struct EpiResF32 {
    static constexpr bool PERM = false, AFTER_DRAIN = false;
    float* C; const float* R; int ldc; float alpha;
    __device__ __forceinline__ void operator()(const f32x4 (&acc)[2][2][4][2], const Unit& u, int wr, int wc, int fr, int fq) const {
        const int row0 = u.pm * BM + wr * 64 + fr, col0 = u.pn * BM + wc * 32 + 4 * fq;
#pragma unroll
        for (int ai = 0; ai < 2; ++ai)
#pragma unroll
            for (int m = 0; m < 4; ++m) { const size_t off = (size_t)(row0 + ai * HALF + m * 16) * ldc + col0;
#pragma unroll
                for (int bj = 0; bj < 2; ++bj)
#pragma unroll
                    for (int n = 0; n < 2; ++n) { const f32x4 r = *(const f32x4*)(R + off + bj * HALF + n * 16); *(f32x4*)(C + off + bj * HALF + n * 16) = r * alpha + acc[ai][bj][m][n]; } }
    }
};
struct EpiResBf16 {
    static constexpr bool PERM = true, AFTER_DRAIN = false;
    bf16_t* O; const float* R; int ldc; float alpha;
    __device__ __forceinline__ void operator()(const f32x4 (&acc)[2][2][4][2], const Unit& u, int wr, int wc, int fr, int fq) const {
        const int row0 = u.pm * BM + wr * 64 + fr, col0 = u.pn * BM + wc * 32 + 8 * fq;
#pragma unroll
        for (int ai = 0; ai < 2; ++ai)
#pragma unroll
            for (int m = 0; m < 4; ++m) { const size_t off = (size_t)(row0 + ai * HALF + m * 16) * ldc + col0;
#pragma unroll
                for (int bj = 0; bj < 2; ++bj) { const f32x4 r0 = *(const f32x4*)(R + off + bj * HALF), r1 = *(const f32x4*)(R + off + bj * HALF + 4);
                    const f32x4 v0 = r0 * alpha + acc[ai][bj][m][0], v1 = r1 * alpha + acc[ai][bj][m][1];
                    u32x4 w; w.x = cvt_pk_bf16(v0[0], v0[1]); w.y = cvt_pk_bf16(v0[2], v0[3]); w.z = cvt_pk_bf16(v1[0], v1[1]); w.w = cvt_pk_bf16(v1[2], v1[3]);
                    *(u32x4*)(O + off + bj * HALF) = w; } }
    }
};

__device__ __forceinline__ void ln1_row_stats(const float* sp, int r, float& mean, float& rstd) {
    const float* p = sp + (size_t)(r >> 8) * 2048 + 2 * (r & 255);
    const float s0 = ((p[0] + p[512]) + p[1024]) + p[1536], s1 = ((p[1] + p[513]) + p[1025]) + p[1537];
    mean = s0 * (1.f / 2048.f); rstd = 1.f / sqrtf(fmaxf(s1 * (1.f / 2048.f) - mean * mean, 0.f) + LN_EPS);
}
struct EpiLNFold {
    static constexpr bool PERM = true, AFTER_DRAIN = false;
    bf16_t* O; int ldc; const float* st; const float* csum; const float* bvec;
    __device__ __forceinline__ void operator()(const f32x4 (&acc)[2][2][4][2], const Unit& u, int wr, int wc, int fr, int fq) const {
        const int row0 = u.pm * BM + wr * 64 + fr, col0 = u.pn * BM + wc * 32 + 8 * fq;
#pragma unroll
        for (int ai = 0; ai < 2; ++ai)
#pragma unroll
            for (int m = 0; m < 4; ++m) { const int r = row0 + ai * HALF + m * 16; bf16_t* rowp = O + (size_t)r * ldc + col0;
                float mean, rstd; ln1_row_stats(st, r, mean, rstd); const float nm = -mean * rstd;
#pragma unroll
                for (int bj = 0; bj < 2; ++bj) { const float* cp = csum + col0 + bj * HALF; const float* bp = bvec + col0 + bj * HALF;
                    const f32x4 c0 = *(const f32x4*)cp, c1 = *(const f32x4*)(cp + 4), b0 = *(const f32x4*)bp, b1 = *(const f32x4*)(bp + 4);
                    const f32x4 v0 = acc[ai][bj][m][0] * rstd + (c0 * nm + b0), v1 = acc[ai][bj][m][1] * rstd + (c1 * nm + b1);
                    u32x4 w; w.x = cvt_pk_bf16(v0[0], v0[1]); w.y = cvt_pk_bf16(v0[2], v0[3]); w.z = cvt_pk_bf16(v1[0], v1[1]); w.w = cvt_pk_bf16(v1[2], v1[3]);
                    *(u32x4*)(rowp + bj * HALF) = w; } }
    }
};
typedef __bf16 bf2_t __attribute__((ext_vector_type(2)));
struct EpiResBf16St {
    static constexpr bool PERM = true, AFTER_DRAIN = false;
    bf16_t* O; const float* R; int ldc; float alpha; PG8_LAS float* lst; float* gst;
    __device__ __forceinline__ void operator()(const f32x4 (&acc)[2][2][4][2], const Unit& u, int wr, int wc, int fr, int fq) const {
        const int row0 = u.pm * BM + wr * 64 + fr, col0 = u.pn * BM + wc * 32 + 8 * fq;
#pragma unroll
        for (int ai = 0; ai < 2; ++ai)
#pragma unroll
            for (int m = 0; m < 4; ++m) { const size_t off = (size_t)(row0 + ai * HALF + m * 16) * ldc + col0; float sm = 0.f, sq = 0.f;
#pragma unroll
                for (int bj = 0; bj < 2; ++bj) { const f32x4 r0 = *(const f32x4*)(R + off + bj * HALF), r1 = *(const f32x4*)(R + off + bj * HALF + 4);
                    const f32x4 v0 = r0 * alpha + acc[ai][bj][m][0], v1 = r1 * alpha + acc[ai][bj][m][1];
                    u32x4 w; w.x = cvt_pk_bf16(v0[0], v0[1]); w.y = cvt_pk_bf16(v0[2], v0[3]); w.z = cvt_pk_bf16(v1[0], v1[1]); w.w = cvt_pk_bf16(v1[2], v1[3]);
                    *(u32x4*)(O + off + bj * HALF) = w;
                    const unsigned one2 = 0x3F803F80u; const unsigned wx = w.x, wy = w.y, wz = w.z, ww = w.w;
#define PG8_ST(q_) do { const bf2_t b_ = __builtin_bit_cast(bf2_t, q_); sm = __builtin_amdgcn_fdot2_f32_bf16(b_, __builtin_bit_cast(bf2_t, one2), sm, false); sq = __builtin_amdgcn_fdot2_f32_bf16(b_, b_, sq, false); } while (0)
                    PG8_ST(wx); PG8_ST(wy); PG8_ST(wz); PG8_ST(ww);
#undef PG8_ST
                    }
                { auto r = __builtin_amdgcn_permlane32_swap(__float_as_uint(sm), __float_as_uint(sm), false, false); sm = __uint_as_float(r[0]) + __uint_as_float(r[1]); }
                { auto r = __builtin_amdgcn_permlane16_swap(__float_as_uint(sm), __float_as_uint(sm), false, false); sm = __uint_as_float(r[0]) + __uint_as_float(r[1]); }
                { auto r = __builtin_amdgcn_permlane32_swap(__float_as_uint(sq), __float_as_uint(sq), false, false); sq = __uint_as_float(r[0]) + __uint_as_float(r[1]); }
                { auto r = __builtin_amdgcn_permlane16_swap(__float_as_uint(sq), __float_as_uint(sq), false, false); sq = __uint_as_float(r[0]) + __uint_as_float(r[1]); }
                if (fq == 0) { const int rl = ai * HALF + wr * 64 + m * 16 + fr;
                    if (lst) { PG8_LAS float* lp = lst + ((u.ord & 1) * 4 + wc) * 512 + 2 * rl; lp[0] = sm; lp[1] = sq; }
                    else { float* gp = gst + (size_t)u.pm * 2048 + 2 * rl; __hip_atomic_fetch_add(gp, sm, __ATOMIC_RELAXED, __HIP_MEMORY_SCOPE_AGENT); __hip_atomic_fetch_add(gp + 1, sq, __ATOMIC_RELAXED, __HIP_MEMORY_SCOPE_AGENT); } } }
    }
};

template <class Epi, class Sched, bool ALIGN_EPI = false, bool SP2 = false>
__device__ __forceinline__ void gemm_phase(PG8_LAS unsigned char* lds, const Gemm g, const Sched& S, const Epi& E, const int tid_in  ) {
    const int tid = tid_in, wid = __builtin_amdgcn_readfirstlane(tid >> 6), lane = tid & 63, wr = wid >> 2, wc = wid & 3, fr = lane & 15, fq = lane >> 4;
    const int K = g.K, nt = K / BK;
    unsigned voffA[2], voffB[2];
#pragma unroll
    for (int i = 0; i < 2; ++i) { int R, C; stage_rc(tid * 16 + i * 8192, R, C); const int Rb = Epi::PERM ? ((R & ~31) + perm32(R & 31)) : R;
        voffA[i] = (unsigned)(R * g.lda + C) * 2u; voffB[i] = (unsigned)(Rb * g.ldb + C) * 2u; }
    const size_t kstep = (size_t)(BK * 2);
    const size_t hsA = (size_t)HALF * g.lda * 2, hsB = (size_t)HALF * g.ldb * 2;
    const size_t tsA = 2 * hsA, tsB = 2 * hsB, pnA = (size_t)g.a_pn_off * 2;
    const unsigned ldsw = (unsigned)wid * 1024u;
    const int aoff = lds_byte(wr * 64 + fr, fq * 8), boff = lds_byte(wc * 32 + fr, fq * 8);
#define PG8_SA(b, h) (((b) * 2 + (h)) * HTB)
#define PG8_SB(b, h) ((4 + (b) * 2 + (h)) * HTB)
#define PG8_STAGE(bufoff, gbase, voff) do { _Pragma("unroll") for (int _i = 0; _i < 2; ++_i) \
        __builtin_amdgcn_global_load_lds((const unsigned*)((const char*)(gbase) + (voff)[_i]), (PG8_LAS unsigned*)(lds + (bufoff) + ldsw + _i * 8192), 16, 0, 0); } while (0)
#define PG8_LDA(dst, b, h) do { _Pragma("unroll") for (int m = 0; m < 4; ++m) _Pragma("unroll") for (int k = 0; k < 2; ++k) dst[m][k] = *(const PG8_LAS bf16x8*)(lds + PG8_SA(b, h) + aoff + m * 2048 + k * 1024); } while (0)
#define PG8_LDB(dst, b, h) do { _Pragma("unroll") for (int n = 0; n < 2; ++n) _Pragma("unroll") for (int k = 0; k < 2; ++k) dst[n][k] = *(const PG8_LAS bf16x8*)(lds + PG8_SB(b, h) + boff + n * 2048 + k * 1024); } while (0)
#define PG8_MMA(ai, bj, At, Bt) do { __builtin_amdgcn_s_setprio(1); _Pragma("unroll") for (int m = 0; m < 4; ++m) _Pragma("unroll") for (int n = 0; n < 2; ++n) _Pragma("unroll") for (int k = 0; k < 2; ++k) \
        acc[ai][bj][m][n] = __builtin_amdgcn_mfma_f32_16x16x32_bf16(Bt[n][k], At[m][k], acc[ai][bj][m][n], 0, 0, 0); __builtin_amdgcn_s_setprio(0); } while (0)
#define PG8_WAIT_V(n) asm volatile("s_waitcnt vmcnt(" #n ")" ::: "memory")
#define PG8_WAIT_L(n) asm volatile("s_waitcnt lgkmcnt(" #n ")" ::: "memory")
#define PG8_BAR __builtin_amdgcn_s_barrier()
#define PG8_SCHED __builtin_amdgcn_sched_barrier(0)
    Unit cur, nxt; int ui = 0;
    if (!S.next(0, cur)) return;
    f32x4 acc[2][2][4][2];
#pragma unroll
    for (int a = 0; a < 2; ++a)
#pragma unroll
        for (int b = 0; b < 2; ++b)
#pragma unroll
            for (int m = 0; m < 4; ++m)
#pragma unroll
                for (int n = 0; n < 2; ++n) acc[a][b][m][n] = (f32x4){0.f, 0.f, 0.f, 0.f};
    bf16x8 At[4][2], B0[2][2], B1[2][2];
    const char* cA = (const char*)g.A + (size_t)cur.pm * tsA + (size_t)cur.pn * pnA; const char* cB = (const char*)g.Bt + (size_t)cur.pn * tsB;
    S.a_ready(cur);
    if constexpr (SP2) {
        PG8_STAGE(PG8_SB(0, 0), cB, voffB); PG8_STAGE(PG8_SB(0, 1), cB + hsB, voffB); PG8_STAGE(PG8_SA(0, 0), cA, voffA); PG8_STAGE(PG8_SA(0, 1), cA + hsA, voffA);
        if (wr == 1) PG8_BAR;
        PG8_WAIT_V(2); PG8_BAR;
        PG8_STAGE(PG8_SB(1, 0), cB + kstep, voffB); PG8_STAGE(PG8_SA(1, 0), cA + kstep, voffA); PG8_STAGE(PG8_SB(1, 1), cB + hsB + kstep, voffB);
        PG8_WAIT_V(6); PG8_BAR;
    } else {
        PG8_STAGE(PG8_SB(0, 0), cB, voffB); PG8_STAGE(PG8_SA(0, 0), cA, voffA); PG8_STAGE(PG8_SB(0, 1), cB + hsB, voffB); PG8_STAGE(PG8_SA(0, 1), cA + hsA, voffA);
        if (wr == 1) PG8_BAR;
        PG8_WAIT_V(4); PG8_BAR;
        PG8_STAGE(PG8_SB(1, 0), cB + kstep, voffB); PG8_STAGE(PG8_SA(1, 0), cA + kstep, voffA); PG8_STAGE(PG8_SB(1, 1), cB + hsB + kstep, voffB);
        PG8_WAIT_V(6); PG8_BAR;
    }
    for (;;) {
        const bool has_next = S.next(ui + 1, nxt);
        const bool b1on = (cur.pn != g.narrow_pn);
        const char* nA = has_next ? (const char*)g.A + (size_t)nxt.pm * tsA + (size_t)nxt.pn * pnA : cA; const char* nB = has_next ? (const char*)g.Bt + (size_t)nxt.pn * tsB : cB;
        for (int t = 0; t < nt; t += 2) {
            const bool last = (t == nt - 2);
            const char* a1 = cA + (size_t)(t + 1) * kstep;
            const char* a2 = last ? nA : cA + (size_t)(t + 2) * kstep; const char* b2 = last ? nB : cB + (size_t)(t + 2) * kstep;
            const char* a3 = a2 + kstep; const char* b3 = b2 + kstep;
            if (last && has_next) S.a_ready(nxt);
            if constexpr (SP2) {
            PG8_LDB(B0, 0, 0); PG8_LDB(B1, 0, 1); PG8_SCHED; PG8_LDA(At, 0, 0); PG8_STAGE(PG8_SA(1, 1), a1 + hsA, voffA);
            PG8_WAIT_V(8); PG8_WAIT_L(0); PG8_BAR; PG8_MMA(0, 0, At, B0); if (b1on) PG8_MMA(0, 1, At, B1); PG8_BAR; PG8_SCHED;
            PG8_LDA(At, 0, 1); PG8_STAGE(PG8_SB(0, 0), b2, voffB); PG8_STAGE(PG8_SB(0, 1), b2 + hsB, voffB); PG8_STAGE(PG8_SA(0, 0), a2, voffA);
            PG8_WAIT_V(8); PG8_WAIT_L(0); PG8_BAR; PG8_MMA(1, 0, At, B0); if (b1on) PG8_MMA(1, 1, At, B1); PG8_BAR; PG8_SCHED;
            PG8_LDB(B0, 1, 0); PG8_LDB(B1, 1, 1); PG8_SCHED; PG8_LDA(At, 1, 0); PG8_STAGE(PG8_SA(0, 1), a2 + hsA, voffA);
            PG8_WAIT_V(8); PG8_WAIT_L(0); PG8_BAR; PG8_MMA(0, 0, At, B0); if (b1on) PG8_MMA(0, 1, At, B1); PG8_BAR; PG8_SCHED;
            PG8_LDA(At, 1, 1); PG8_STAGE(PG8_SB(1, 0), b3, voffB); PG8_STAGE(PG8_SB(1, 1), b3 + hsB, voffB); PG8_STAGE(PG8_SA(1, 0), a3, voffA);
            PG8_WAIT_V(8); PG8_WAIT_L(0); PG8_BAR; PG8_MMA(1, 0, At, B0); if (b1on) PG8_MMA(1, 1, At, B1); PG8_BAR; PG8_SCHED;
            } else {
            PG8_LDB(B0, 0, 0); PG8_SCHED; PG8_LDA(At, 0, 0); PG8_STAGE(PG8_SA(1, 1), a1 + hsA, voffA);
            PG8_WAIT_L(8); PG8_BAR; PG8_WAIT_L(0); PG8_MMA(0, 0, At, B0); PG8_BAR; PG8_SCHED;
            PG8_LDB(B1, 0, 1); PG8_STAGE(PG8_SB(0, 0), b2, voffB);
            PG8_BAR; PG8_WAIT_L(0); PG8_MMA(0, 1, At, B1); PG8_BAR;
            PG8_LDA(At, 0, 1); PG8_STAGE(PG8_SA(0, 0), a2, voffA);
            PG8_BAR; PG8_WAIT_L(0); PG8_MMA(1, 0, At, B0); PG8_BAR; PG8_SCHED;
            PG8_STAGE(PG8_SB(0, 1), b2 + hsB, voffB);
            PG8_WAIT_V(6); PG8_BAR; PG8_MMA(1, 1, At, B1); PG8_BAR;
            PG8_LDB(B0, 1, 0); PG8_SCHED; PG8_LDA(At, 1, 0); PG8_STAGE(PG8_SA(0, 1), a2 + hsA, voffA);
            PG8_WAIT_L(8); PG8_BAR; PG8_WAIT_L(0); PG8_MMA(0, 0, At, B0); PG8_BAR; PG8_SCHED;
            PG8_LDB(B1, 1, 1); PG8_STAGE(PG8_SB(1, 0), b3, voffB);
            PG8_BAR; PG8_WAIT_L(0); PG8_MMA(0, 1, At, B1); PG8_BAR;
            PG8_LDA(At, 1, 1); PG8_STAGE(PG8_SA(1, 0), a3, voffA);
            PG8_BAR; PG8_WAIT_L(0); PG8_MMA(1, 0, At, B0); PG8_BAR; PG8_SCHED;
            PG8_STAGE(PG8_SB(1, 1), b3 + hsB, voffB);
            PG8_WAIT_V(6); PG8_BAR; PG8_MMA(1, 1, At, B1); PG8_BAR;
            }
        }
        if constexpr (ALIGN_EPI) { if (wr == 0) PG8_BAR; }
        if constexpr (!Epi::AFTER_DRAIN) { E(acc, cur, wr, wc, fr, fq); S.done(cur); }
        if (!has_next) break;
#pragma unroll
        for (int a = 0; a < 2; ++a)
#pragma unroll
            for (int b = 0; b < 2; ++b)
#pragma unroll
                for (int m = 0; m < 4; ++m)
#pragma unroll
                    for (int n = 0; n < 2; ++n) acc[a][b][m][n] = (f32x4){0.f, 0.f, 0.f, 0.f};
        cur = nxt; cA = nA; cB = nB; ++ui;
        if constexpr (ALIGN_EPI) { if (wr == 1) PG8_BAR; }
    }
    PG8_WAIT_V(0);
    if constexpr (!ALIGN_EPI) { if (wr == 0) PG8_BAR; }
    PG8_BAR;
    if constexpr (Epi::AFTER_DRAIN) { E.fused(acc, cur, wr, wc, fr, fq, lds, wid, lane); S.done(cur); }
#undef PG8_SA
#undef PG8_SB
#undef PG8_STAGE
#undef PG8_LDA
#undef PG8_LDB
#undef PG8_MMA
#undef PG8_WAIT_V
#undef PG8_WAIT_L
#undef PG8_BAR
#undef PG8_SCHED
}
}
#define GAS __attribute__((address_space(1)))
#define LAS __attribute__((address_space(3)))
typedef unsigned short bf16;
typedef unsigned v4u __attribute__((ext_vector_type(4)));
typedef float f32x4 __attribute__((ext_vector_type(4)));
typedef short bf16x8 __attribute__((ext_vector_type(8)));
typedef GAS unsigned gu32;
typedef GAS unsigned long long gu64;
#define RLX_AGENT __ATOMIC_RELAXED, __HIP_MEMORY_SCOPE_AGENT
#define LDS_WAIT() asm volatile("s_waitcnt lgkmcnt(0)" ::: "memory")
#define VM_WAIT() asm volatile("s_waitcnt vmcnt(0)" ::: "memory")
__device__ __forceinline__ unsigned long long rt() { return __builtin_amdgcn_s_memrealtime(); }
__device__ __forceinline__ unsigned f2bf(float f) { unsigned u = __builtin_bit_cast(unsigned, f); return (u + 0x7fffu + ((u >> 16) & 1u)) >> 16; }
__device__ __forceinline__ unsigned pk2(float lo, float hi) { return f2bf(lo) | (f2bf(hi) << 16); }

#define XB_TMO      128
#define XB_XCNT(j)  (256  + 64 * (j))
#define XB_XSUB(j)  (1280 + 64 * (j))
#define XB_XGEN(j)  (2304 + 64 * (j))
#define XB_TOP      3328
#define XB_TOPGEN   3392
#define XCD_BAR_WORDS 3456
#define XB_SPIN_CAP (1u << 24)

__device__ __forceinline__ unsigned xb_ld(unsigned* p)              { return __hip_atomic_load(p, __ATOMIC_RELAXED, __HIP_MEMORY_SCOPE_AGENT); }
__device__ __forceinline__ unsigned xb_add(unsigned* p, unsigned v) { return __hip_atomic_fetch_add(p, v, __ATOMIC_RELAXED, __HIP_MEMORY_SCOPE_AGENT); }
__device__ __forceinline__ unsigned xb_xcc_id() { return (unsigned)__builtin_amdgcn_s_getreg((3 << 11) | 20) & 0xFu; }
#define XB_SPIN(cond, bar) do { unsigned _sp = 0; while (cond) { __builtin_amdgcn_s_sleep(1); \
    if ((++_sp & 255u) == 0u) { if (xb_ld(&(bar)[XB_TMO])) break; if (_sp > XB_SPIN_CAP) { atomicAdd(&(bar)[XB_TMO], 1u); break; } } } } while (0)

struct XcdBarrier {
    unsigned* bar; unsigned x;
    volatile LAS unsigned* st;
};

__device__ __forceinline__ XcdBarrier xcd_barrier_post(unsigned* bar, volatile LAS unsigned* st) {
    XcdBarrier b; b.bar = bar; b.x = xb_xcc_id(); b.st = st;
    if (threadIdx.x == 0) (void)xb_add(&bar[XB_XCNT(b.x)], 1u);
    return b;
}
__device__ __forceinline__ void xcd_barrier_complete(unsigned* bar, unsigned x, unsigned& nloc, unsigned& nx) {
    const unsigned G = gridDim.x * gridDim.y * gridDim.z;
    unsigned sum, cnt, mine, sp = 0u;
    for (;;) {
        sum = 0u; cnt = 0u; mine = 0u;
#pragma unroll
        for (unsigned j = 0; j < 16; ++j) { const unsigned c = xb_ld(&bar[XB_XCNT(j)]); sum += c; cnt += (c > 0u) ? 1u : 0u; mine = (j == x) ? c : mine; }
        if (sum == G) break;
        __builtin_amdgcn_s_sleep(1);
        if ((++sp & 255u) == 0u) { if (xb_ld(&bar[XB_TMO])) break; if (sp > XB_SPIN_CAP) { atomicAdd(&bar[XB_TMO], 1u); break; } }
    }
    nloc = mine > 0u ? mine : 1u; nx = cnt > 0u ? cnt : 1u;
}

__device__ __forceinline__ void xcd_barrier(const XcdBarrier& b) {
    asm volatile("s_waitcnt vmcnt(0)" ::: "memory");
    __syncthreads();
    if (threadIdx.x == 0) {
        unsigned* bar = b.bar;
        __builtin_amdgcn_s_waitcnt(0);
        unsigned nloc = b.st[0], nx = b.st[1];
        if (nloc == 0u) { xcd_barrier_complete(bar, b.x, nloc, nx); b.st[0] = nloc; b.st[1] = nx; }
        const unsigned old = xb_add(&bar[XB_XSUB(b.x)], 1u);
        const unsigned gen = old / nloc;
        if (old + 1u == (gen + 1u) * nloc) {
            __builtin_amdgcn_fence(__ATOMIC_RELEASE, "agent");
            asm volatile("s_waitcnt vmcnt(0)" ::: "memory");
            const unsigned og = xb_add(&bar[XB_TOP], 1u);
            const unsigned tg = og / nx;
            if (og + 1u == (tg + 1u) * nx) xb_add(&bar[XB_TOPGEN], 1u);
            else XB_SPIN(xb_ld(&bar[XB_TOPGEN]) == tg, bar);
            __builtin_amdgcn_fence(__ATOMIC_ACQUIRE, "agent");
            xb_add(&bar[XB_XGEN(b.x)], 1u);
            asm volatile("s_waitcnt vmcnt(0)" ::: "memory");
        } else {
            XB_SPIN(xb_ld(&bar[XB_XGEN(b.x)]) == gen, bar);
            __builtin_amdgcn_fence(__ATOMIC_ACQUIRE, "agent");
            asm volatile("s_waitcnt vmcnt(0)" ::: "memory");
        }
    }
    __syncthreads();
}
constexpr int NWAVES = 8, NTHREADS = 512;
constexpr int RING_OFF = 0, RING_BYTES = 131072, LDSCTL_OFF = RING_BYTES, MISC_OFF = LDSCTL_OFF + 320, LDS_BYTES = 163840;
typedef unsigned u32x2 __attribute__((ext_vector_type(2)));
typedef unsigned u32x4 __attribute__((ext_vector_type(4)));

__device__ __forceinline__ float bf2f(unsigned short b) { return __builtin_bit_cast(float, (unsigned)b << 16); }
__device__ __forceinline__ float bflo(unsigned w) { return __builtin_bit_cast(float, w << 16); }
__device__ __forceinline__ float bfhi(unsigned w) { return __builtin_bit_cast(float, w & 0xffff0000u); }
__device__ __forceinline__ float wave_sum(float v) {
#pragma unroll
    for (int o = 1; o < 64; o <<= 1) v += __shfl_xor(v, o);
    return v;
}
__device__ __forceinline__ float wave_max(float v) {
#pragma unroll
    for (int o = 1; o < 64; o <<= 1) v = fmaxf(v, __shfl_xor(v, o));
    return v;
}
__device__ __forceinline__ int wave_min_i(int v) {
#pragma unroll
    for (int o = 1; o < 64; o <<= 1) v = min(v, __shfl_xor(v, o));
    return v;
}

struct Frame {
    LAS unsigned char* lds;
    unsigned char* ldsg;
    int tid, lane, wave, vcu, G;
};

__device__ __forceinline__ void p0_transpose_item(const float* W, int K, int N, int Npad, bf16* WT, int row_off, LAS float* scr, int item, int lane) {
    const int nblk = Npad / 32, kb = item / nblk, nb = item % nblk, k0 = 64 * kb, n0 = 32 * nb;
    const int ncol = n0 + (lane & 31);
    float tv[32];
#pragma unroll
    for (int i = 0; i < 32; ++i) { const int kk = 2 * i + (lane >> 5); tv[i] = (ncol < N) ? W[(size_t)(k0 + kk) * N + ncol] : 0.f; }
#pragma unroll
    for (int i = 0; i < 32; ++i) { const int kk = 2 * i + (lane >> 5); scr[kk * 33 + (lane & 31)] = tv[i]; }
    LDS_WAIT(); asm volatile("" ::: "memory");
    const int c = lane & 7;
#pragma unroll
    for (int j = 0; j < 4; ++j) { const int n = (lane >> 3) + 8 * j; const LAS float* s = scr + (8 * c) * 33 + n;
        v4u o; o.x = pk2(s[0 * 33], s[1 * 33]); o.y = pk2(s[2 * 33], s[3 * 33]); o.z = pk2(s[4 * 33], s[5 * 33]); o.w = pk2(s[6 * 33], s[7 * 33]);
        *(GAS v4u*)(WT + (size_t)(row_off + n0 + n) * K + k0 + 8 * c) = o; }
    LDS_WAIT(); asm volatile("" ::: "memory");
}
__device__ __forceinline__ void p0_transpose_item_ln(const float* W, bf16* WT, LAS float* scr, int item, int lane, const float* g, const float* b, float* csum, float* bvec) {
    constexpr int K = 2048, N = 2048; const int nblk = N / 32, kb = item / nblk, nb = item % nblk, k0 = 64 * kb, n0 = 32 * nb;
    const int ncol = n0 + (lane & 31);
    float tv[32];
#pragma unroll
    for (int i = 0; i < 32; ++i) { const int kk = 2 * i + (lane >> 5); tv[i] = W[(size_t)(k0 + kk) * N + ncol]; }
    float cs = 0.f, bs = 0.f;
#pragma unroll
    for (int i = 0; i < 32; ++i) { const int kk = 2 * i + (lane >> 5); const float w = tv[i]; bs += w * b[k0 + kk];
        const float wr = __builtin_bit_cast(float, f2bf(w * g[k0 + kk]) << 16); cs += wr; scr[kk * 33 + (lane & 31)] = wr; }
    { auto r = __builtin_amdgcn_permlane32_swap(__float_as_uint(cs), __float_as_uint(cs), false, false); cs = __uint_as_float(r[0]) + __uint_as_float(r[1]); }
    { auto r = __builtin_amdgcn_permlane32_swap(__float_as_uint(bs), __float_as_uint(bs), false, false); bs = __uint_as_float(r[0]) + __uint_as_float(r[1]); }
    if (lane < 32) { csum[(size_t)kb * 2048 + ncol] = cs; bvec[(size_t)kb * 2048 + ncol] = bs; }
    LDS_WAIT(); asm volatile("" ::: "memory");
    const int c = lane & 7;
#pragma unroll
    for (int j = 0; j < 4; ++j) { const int n = (lane >> 3) + 8 * j; const LAS float* s = scr + (8 * c) * 33 + n;
        v4u o; o.x = pk2(s[0 * 33], s[1 * 33]); o.y = pk2(s[2 * 33], s[3 * 33]); o.z = pk2(s[4 * 33], s[5 * 33]); o.w = pk2(s[6 * 33], s[7 * 33]);
        *(GAS v4u*)(WT + (size_t)(n0 + n) * K + k0 + 8 * c) = o; }
    LDS_WAIT(); asm volatile("" ::: "memory");
}
__device__ __forceinline__ void cvt_stream(const Frame& F, const float* in, bf16* out, size_t n8, int widx, int nwork) {
    const size_t T = (size_t)nwork * NTHREADS;
    for (size_t i0 = (size_t)widx * NTHREADS + F.tid; i0 < n8; i0 += 4 * T) {
        f32x4 a[4], b[4];
#pragma unroll
        for (int u = 0; u < 4; ++u) { const size_t i = i0 + u * T; if (i < n8) { a[u] = ((const f32x4*)in)[2 * i]; b[u] = ((const f32x4*)in)[2 * i + 1]; } }
#pragma unroll
        for (int u = 0; u < 4; ++u) { const size_t i = i0 + u * T; if (i < n8) {
            v4u w; w.x = pk2(a[u].x, a[u].y); w.y = pk2(a[u].z, a[u].w); w.z = pk2(b[u].x, b[u].y); w.w = pk2(b[u].z, b[u].w);
            ((v4u*)out)[i] = w; } }
    }
}
__device__ __forceinline__ void cvt_rows_fp4(const Frame& F, const float* tab, unsigned char* t4, float* inv_scale, int row_begin, int row_end, int widx, int nwork);
__device__ __forceinline__ void p0_first(const Frame& F, const float* x, const float* w_in, bf16* XB, bf16* WinT) {
    LAS float* scr = (LAS float*)(F.lds + RING_OFF + F.wave * 16384);
    const int gw = F.vcu * NWAVES + F.wave, NGW = F.G * NWAVES;
    constexpr int I_IN = (2048 / 64) * (D_IN_PAD / 32);
    for (int it = gw; it < I_IN; it += NGW) p0_transpose_item(w_in, 2048, D_IN, D_IN_PAD, WinT, 0, scr, it, F.lane);
    cvt_stream(F, x, XB, (size_t)M_TOK * 2048 / 8, F.vcu, F.G);
}
__device__ __forceinline__ void p0_deferred(const Frame& F, int widx, int nwork, const float* pool_w, const float* w_out, const float* wq, bf16* PoolWT, bf16* WoutT, bf16* WqT,
                                            const float* g1, const float* b1, float* csum, float* bvec, const float* peer_sub, bf16* SKB,
                                            const float* peer_u, const float* peer_v, unsigned char* U8, float* ISU, float* ISV) {
    LAS float* scr = (LAS float*)(F.lds + RING_OFF + F.wave * 16384);
    const int gw = widx * NWAVES + F.wave, NGW = nwork * NWAVES;
    constexpr int I_SQ = (2048 / 64) * (2048 / 32), I_PG = (256 / 64) * (256 / 32);
    constexpr int NITEMS = 2 * I_SQ + 4 * I_PG;
    for (int it = gw; it < NITEMS; it += NGW) {
        int r = it;
        if (r < I_SQ) { p0_transpose_item(w_out, 2048, 2048, 2048, WoutT, 0, scr, r, F.lane); continue; } r -= I_SQ;
        if (r < I_SQ) { p0_transpose_item_ln(wq, WqT, scr, r, F.lane, g1, b1, csum, bvec); continue; } r -= I_SQ;
        const int g = r / I_PG; r -= g * I_PG;
        p0_transpose_item(pool_w + (size_t)g * 65536, 256, 256, 256, PoolWT, g * 256, scr, r, F.lane);
    }
    cvt_stream(F, peer_sub, SKB, (size_t)2 * 128 * 128 / 8, widx, nwork);
    cvt_rows_fp4(F, peer_u, U8, ISU, 0, N_EXPERTS, widx, nwork);
    cvt_rows_fp4(F, peer_v, U8 + 1024, ISV, 0, N_EXPERTS, widx, nwork);
}

__device__ __forceinline__ void ln1_fold_reduce(const Frame& F, const float* csp, const float* bvp, float* csum, float* bvec) {
    const int n = F.vcu * NTHREADS + F.tid;
    if (n < 2048) { float a = 0.f, b = 0.f;
#pragma unroll 8
        for (int kb = 0; kb < 32; ++kb) { a += csp[(size_t)kb * 2048 + n]; b += bvp[(size_t)kb * 2048 + n]; }
        csum[n] = a; bvec[n] = b; }
}

template <int W> __device__ __forceinline__ void pool_item(const bf16* pv, bf16* pooled, int m0, int t0, int c8) {
    constexpr int NR = W + 15;
    v4u rv[NR];
#pragma unroll
    for (int k = 0; k < NR; ++k) { const int dt = k - (W - 1); rv[k] = (v4u){0u, 0u, 0u, 0u}; if (t0 + dt >= 0) rv[k] = *(const v4u*)(pv + (size_t)(m0 + dt) * 1024 + c8); }
    float s[8] = {0.f, 0.f, 0.f, 0.f, 0.f, 0.f, 0.f, 0.f};
#define PP_ADD(k_, sg_) do { const unsigned x_ = rv[k_].x, y_ = rv[k_].y, z_ = rv[k_].z, q_ = rv[k_].w; \
        s[0] += sg_ * bflo(x_); s[1] += sg_ * bfhi(x_); s[2] += sg_ * bflo(y_); s[3] += sg_ * bfhi(y_); s[4] += sg_ * bflo(z_); s[5] += sg_ * bfhi(z_); s[6] += sg_ * bflo(q_); s[7] += sg_ * bfhi(q_); } while (0)
#pragma unroll
    for (int k = 0; k < W - 1; ++k) PP_ADD(k, 1.f);
#pragma unroll
    for (int i = 0; i < 16; ++i) {
        PP_ADD(W - 1 + i, 1.f);
        if (i >= 1) PP_ADD(i - 1, -1.f);
        const int t = t0 + i; const float inv = 1.f / (float)(t + 1 < W ? t + 1 : W);
        const unsigned x_ = rv[W - 1 + i].x, y_ = rv[W - 1 + i].y, z_ = rv[W - 1 + i].z, q_ = rv[W - 1 + i].w;
        v4u o; o.x = pk2(s[0] * inv - bflo(x_), s[1] * inv - bfhi(x_)); o.y = pk2(s[2] * inv - bflo(y_), s[3] * inv - bfhi(y_));
        o.z = pk2(s[4] * inv - bflo(z_), s[5] * inv - bfhi(z_)); o.w = pk2(s[6] * inv - bflo(q_), s[7] * inv - bfhi(q_));
        *(v4u*)(pooled + (size_t)(m0 + i) * 1024 + c8) = o;
    }
#undef PP_ADD
}
__device__ __forceinline__ void phase_pool_prep(const Frame& F, const bf16* pv, bf16* pooled) {
    const int total = (M_TOK / 16) * 128;
    for (int i = F.vcu * NTHREADS + F.tid; i < total; i += F.G * NTHREADS) {
        const int tb = i >> 7, c8 = (i & 127) * 8, m0 = tb * 16, t0 = m0 & (SEQ - 1);
        switch (c8 >> 8) {
            case 0: pool_item<2>(pv, pooled, m0, t0, c8); break;
            case 1: pool_item<4>(pv, pooled, m0, t0, c8); break;
            case 2: pool_item<8>(pv, pooled, m0, t0, c8); break;
            default: pool_item<16>(pv, pooled, m0, t0, c8); break;
        }
    }
}

__device__ __forceinline__ unsigned sortable(float f) { const unsigned u = __builtin_bit_cast(unsigned, f); return u ^ ((unsigned)((int)u >> 31) | 0x80000000u); }

__device__ __forceinline__ void phase_indexer_simple(const Frame& F, const bf16* qi, const bf16* kiwi, unsigned* mask) {
    float* qs = (float*)F.ldsg;
    float* wsh = qs + 1024;
    unsigned* keys = (unsigned*)(wsh + 16);
    unsigned* cnt_sh = keys + 4096;
    const int tid = F.tid;
    for (int m = F.vcu; m < M_TOK; m += F.G) {
        const int t = m & (SEQ - 1), b0 = m - t;
        for (int i = tid; i < 1024; i += NTHREADS) qs[i] = bf2f(qi[(size_t)m * 1024 + i]);
        if (tid < 16) wsh[tid] = bf2f(kiwi[(size_t)m * 256 + 64 + tid]);
        __syncthreads();
        const int n = t + 1;
        for (int s = tid; s < n; s += NTHREADS) {
            const v4u* kp = (const v4u*)(kiwi + (size_t)(b0 + s) * 256);
            float kf[64];
#pragma unroll
            for (int i = 0; i < 8; ++i) { const v4u w = kp[i];
                kf[8 * i + 0] = bflo(w.x); kf[8 * i + 1] = bfhi(w.x); kf[8 * i + 2] = bflo(w.y); kf[8 * i + 3] = bfhi(w.y);
                kf[8 * i + 4] = bflo(w.z); kf[8 * i + 5] = bfhi(w.z); kf[8 * i + 6] = bflo(w.w); kf[8 * i + 7] = bfhi(w.w); }
            float sc = 0.f;
#pragma unroll 1
            for (int h = 0; h < 16; ++h) {
                float d = 0.f;
#pragma unroll
                for (int i = 0; i < 64; ++i) d = fmaf(qs[h * 64 + i], kf[i], d);
                sc = fmaf(wsh[h], fmaxf(d, 0.f), sc);
            }
            keys[s] = sortable(sc);
        }
        __syncthreads();
        unsigned tau = 0u; int need_ties = 0; const bool all = (n <= TOPK);
        if (!all) {
            unsigned prefix = 0u;
#pragma unroll 1
            for (int bit = 31; bit >= 0; --bit) {
                const unsigned cand = prefix | (1u << bit);
                if (tid == 0) *cnt_sh = 0u;
                __syncthreads();
                int c = 0;
                for (int s = tid; s < n; s += NTHREADS) c += (keys[s] >= cand) ? 1 : 0;
                c = (int)wave_sum((float)c);
                if ((tid & 63) == 0) atomicAdd(cnt_sh, (unsigned)c);
                __syncthreads();
                if (*cnt_sh >= (unsigned)TOPK) prefix = cand;
                __syncthreads();
            }
            tau = prefix;
            if (tid == 0) *cnt_sh = 0u;
            __syncthreads();
            int c = 0;
            for (int s = tid; s < n; s += NTHREADS) c += (keys[s] > tau) ? 1 : 0;
            c = (int)wave_sum((float)c);
            if ((tid & 63) == 0) atomicAdd(cnt_sh, (unsigned)c);
            __syncthreads();
            need_ties = TOPK - (int)*cnt_sh;
        }
        for (int s0 = 0; s0 < SEQ; s0 += NTHREADS) {
            const int s = s0 + tid;
            bool sel = false;
            if (s < n) {
                if (all) sel = true;
                else {
                    const unsigned k = keys[s];
                    if (k > tau) sel = true;
                    else if (k == tau) { int r = 0; for (int s2 = 0; s2 < s; ++s2) r += (keys[s2] == tau) ? 1 : 0; sel = r < need_ties; }
                }
            }
            const unsigned long long bal = __ballot(sel);
            if ((tid & 63) == 0) { const int w = s >> 5; mask[(size_t)m * 128 + w] = (unsigned)bal; mask[(size_t)m * 128 + w + 1] = (unsigned)(bal >> 32); }
        }
        __syncthreads();
    }
}

__device__ __forceinline__ int t5_bucket(int dist) {
    if (dist < 16) return dist;
    const float d = (float)dist;
    const int large = 16 + (int)(logf(d / 16.f) / logf(8.f) * 16.f);
    return large < 31 ? large : 31;
}

__device__ __forceinline__ void phase_attn_simple(const Frame& F, const bf16* Q, const bf16* K, const bf16* V, const unsigned* mask, const float* rel_bias, bf16* mixin) {
    int* list = (int*)F.ldsg;
    float* qsh = (float*)(list + 256);
    float* bias2 = qsh + 1024;
    int* nsel_sh = (int*)(bias2 + 129 * 8);
    const int tid = F.tid, lane = F.lane, wid = F.wave;
    for (int i = tid; i < 129 * 8; i += NTHREADS) { const int d = i >> 3, h = i & 7; bias2[i] = rel_bias[t5_bucket(d) * 8 + h] * LOG2E; }
    for (int m = F.vcu; m < M_TOK; m += F.G) {
        const int t = m & (SEQ - 1), b0 = m - t;
        qsh[wid * 128 + lane] = bf2f(Q[(size_t)m * 1024 + wid * 128 + lane]);
        qsh[wid * 128 + lane + 64] = bf2f(Q[(size_t)m * 1024 + wid * 128 + 64 + lane]);
        if (wid == 0) {
            const unsigned w0 = mask[(size_t)m * 128 + 2 * lane], w1 = mask[(size_t)m * 128 + 2 * lane + 1];
            unsigned long long bits = (unsigned long long)w0 | ((unsigned long long)w1 << 32);
            const int c = __popcll(bits);
            int incl = c;
#pragma unroll
            for (int o = 1; o < 64; o <<= 1) { const int v = __shfl_up(incl, o); if (lane >= o) incl += v; }
            int off = incl - c;
            while (bits) { const int pos = __ffsll((long long)bits) - 1; bits &= bits - 1; if (off < 256) list[off] = 64 * lane + pos; ++off; }
            if (lane == 63) *nsel_sh = incl < 256 ? incl : 256;
        }
        __syncthreads();
        const int nsel = *nsel_sh, h = wid;
        float lg[4]; int sidx[4];
#pragma unroll
        for (int j = 0; j < 4; ++j) {
            const int idx = lane + 64 * j;
            lg[j] = -INFINITY; sidx[j] = 0;
            if (idx < nsel) {
                const int s = list[idx]; sidx[j] = s;
                const v4u* kp = (const v4u*)(K + (size_t)(b0 + s) * 1024 + h * 128);
                float d = 0.f;
#pragma unroll
                for (int i = 0; i < 16; ++i) { const v4u w = kp[i]; const float* qq = &qsh[h * 128 + 8 * i];
                    d = fmaf(qq[0], bflo(w.x), d); d = fmaf(qq[1], bfhi(w.x), d); d = fmaf(qq[2], bflo(w.y), d); d = fmaf(qq[3], bfhi(w.y), d);
                    d = fmaf(qq[4], bflo(w.z), d); d = fmaf(qq[5], bfhi(w.z), d); d = fmaf(qq[6], bflo(w.w), d); d = fmaf(qq[7], bfhi(w.w), d); }
                const int dist = t - s;
                lg[j] = d + bias2[(dist < 128 ? dist : 128) * 8 + h];
            }
        }
        float mx = fmaxf(fmaxf(lg[0], lg[1]), fmaxf(lg[2], lg[3])); mx = wave_max(mx);
        float pr[4], ps = 0.f;
#pragma unroll
        for (int j = 0; j < 4; ++j) { pr[j] = exp2f(lg[j] - mx); ps += pr[j]; }
        ps = wave_sum(ps);
        float o0 = 0.f, o1 = 0.f;
        for (int i = 0; i < nsel; ++i) {
            const int j = i >> 6, src = i & 63;
            const float pj = (j == 0) ? pr[0] : (j == 1) ? pr[1] : (j == 2) ? pr[2] : pr[3];
            const int sj = (j == 0) ? sidx[0] : (j == 1) ? sidx[1] : (j == 2) ? sidx[2] : sidx[3];
            const float p = __shfl(pj, src); const int s = __shfl(sj, src);
            const unsigned w = *(const unsigned*)(V + (size_t)(b0 + s) * 1024 + h * 128 + 2 * lane);
            o0 = fmaf(p, bflo(w), o0); o1 = fmaf(p, bfhi(w), o1);
        }
        const float inv = 1.f / ps;
        *(unsigned*)(mixin + (size_t)m * 2048 + 1024 + h * 128 + 2 * lane) = pk2(o0 * inv, o1 * inv);
        __syncthreads();
    }
}

__device__ __forceinline__ float wsum_dpp(float v) {
    v += __builtin_amdgcn_update_dpp(0.f, v, 0xB1, 0xf, 0xf, true);
    v += __builtin_amdgcn_update_dpp(0.f, v, 0x4E, 0xf, 0xf, true);
    v += __builtin_amdgcn_update_dpp(0.f, v, 0x141, 0xf, 0xf, true);
    v += __builtin_amdgcn_update_dpp(0.f, v, 0x140, 0xf, 0xf, true);
    v += __builtin_amdgcn_update_dpp(0.f, v, 0x142, 0xa, 0xf, false);
    v += __builtin_amdgcn_update_dpp(0.f, v, 0x143, 0xc, 0xf, false);
    return __builtin_bit_cast(float, __builtin_amdgcn_readlane(__builtin_bit_cast(int, v), 63));
}
__device__ __forceinline__ void phase_ln1(const Frame& F, const bf16* z, bf16* hb, const float* g, const float* bta, const float* stats) {
    const int lane = F.lane, NGW = F.G * NWAVES;
    int row = F.vcu * NWAVES + F.wave;
    v4u cur[4], nx[4];
    if (row < M_TOK) { const v4u* zr = (const v4u*)(z + (size_t)row * 2048) + lane;
#pragma unroll
        for (int j = 0; j < 4; ++j) cur[j] = zr[64 * j]; }
#pragma unroll 1
    for (; row < M_TOK; row += NGW) {
        const int rn = row + NGW;
        if (rn < M_TOK) { const v4u* zr = (const v4u*)(z + (size_t)rn * 2048) + lane;
#pragma unroll
            for (int j = 0; j < 4; ++j) nx[j] = zr[64 * j]; }
        float v[4][8]; float s = 0.f;
#pragma unroll
        for (int j = 0; j < 4; ++j) { const unsigned wx = cur[j].x, wy = cur[j].y, wz = cur[j].z, ww = cur[j].w;
            v[j][0] = bflo(wx); v[j][1] = bfhi(wx); v[j][2] = bflo(wy); v[j][3] = bfhi(wy); v[j][4] = bflo(wz); v[j][5] = bfhi(wz); v[j][6] = bflo(ww); v[j][7] = bfhi(ww);
#pragma unroll
            for (int i = 0; i < 8; ++i) s += v[j][i]; }
        const float mean = stats[2 * row] * (1.f / 2048.f); (void)s;
#pragma unroll
        for (int j = 0; j < 4; ++j)
#pragma unroll
            for (int i = 0; i < 8; ++i) v[j][i] -= mean;
        const float rstd = 1.f / sqrtf(fmaxf(stats[2 * row + 1] * (1.f / 2048.f) - mean * mean, 0.f) + LN_EPS);
        v4u* ob = (v4u*)(hb + (size_t)row * 2048) + lane;
#pragma unroll
        for (int j = 0; j < 4; ++j) { const int e = 8 * (lane + 64 * j);
            const f32x4 g0 = *(const f32x4*)(g + e), g1 = *(const f32x4*)(g + e + 4), b0 = *(const f32x4*)(bta + e), b1 = *(const f32x4*)(bta + e + 4);
            v4u w; w.x = pk2(v[j][0] * rstd * g0.x + b0.x, v[j][1] * rstd * g0.y + b0.y); w.y = pk2(v[j][2] * rstd * g0.z + b0.z, v[j][3] * rstd * g0.w + b0.w);
            w.z = pk2(v[j][4] * rstd * g1.x + b1.x, v[j][5] * rstd * g1.y + b1.y); w.w = pk2(v[j][6] * rstd * g1.z + b1.z, v[j][7] * rstd * g1.w + b1.w);
            ob[64 * j] = w; }
#pragma unroll
        for (int j = 0; j < 4; ++j) cur[j] = nx[j];
    }
}

typedef float f32x16 __attribute__((ext_vector_type(16)));
typedef float f32x2 __attribute__((ext_vector_type(2)));
__device__ __forceinline__ float unsortable(unsigned k) { const unsigned u = (k & 0x80000000u) ? (k ^ 0x80000000u) : ~k; return __builtin_bit_cast(float, u); }
__device__ __forceinline__ void ce_d(unsigned& a, unsigned& b) { const unsigned mx = a > b ? a : b, mn = a > b ? b : a; a = mx; b = mn; }
__device__ __forceinline__ void ce_dp(unsigned& ka, unsigned& pa, unsigned& kb, unsigned& pb) {
    const bool sw = kb > ka; const unsigned nka = sw ? kb : ka, nkb = sw ? ka : kb, npa = sw ? pb : pa, npb = sw ? pa : pb; ka = nka; kb = nkb; pa = npa; pb = npb; }
template <int BASE, int N> __device__ __forceinline__ void sort16_desc(unsigned (&v)[N]) {
#pragma unroll
    for (int k = 2; k <= 16; k <<= 1)
#pragma unroll
        for (int j = k >> 1; j > 0; j >>= 1)
#pragma unroll
            for (int i = 0; i < 16; ++i) { const int l = i ^ j; if (l > i) { if ((i & k) == 0) ce_d(v[BASE + i], v[BASE + l]); else ce_d(v[BASE + l], v[BASE + i]); } }
}
template <int A, int B, int N> __device__ __forceinline__ void merge16_desc(unsigned (&v)[N]) {
#pragma unroll
    for (int i = 0; i < 16; ++i) v[A + i] = v[A + i] > v[B + 15 - i] ? v[A + i] : v[B + 15 - i];
#pragma unroll
    for (int j = 8; j > 0; j >>= 1)
#pragma unroll
        for (int i = 0; i < 16; ++i) { const int l = i ^ j; if (l > i) ce_d(v[A + i], v[A + l]); }
}
template <int BASE, int N> __device__ __forceinline__ void sort16_desc_p(unsigned (&v)[N], unsigned (&p)[N]) {
#pragma unroll
    for (int k = 2; k <= 16; k <<= 1)
#pragma unroll
        for (int j = k >> 1; j > 0; j >>= 1)
#pragma unroll
            for (int i = 0; i < 16; ++i) { const int l = i ^ j; if (l > i) { if ((i & k) == 0) ce_dp(v[BASE + i], p[BASE + i], v[BASE + l], p[BASE + l]); else ce_dp(v[BASE + l], p[BASE + l], v[BASE + i], p[BASE + i]); } }
}
template <int A, int B, int N> __device__ __forceinline__ void merge16_desc_p(unsigned (&v)[N], unsigned (&p)[N]) {
#pragma unroll
    for (int i = 0; i < 16; ++i) { const bool sw = v[B + 15 - i] > v[A + i]; v[A + i] = sw ? v[B + 15 - i] : v[A + i]; p[A + i] = sw ? p[B + 15 - i] : p[A + i]; }
#pragma unroll
    for (int j = 8; j > 0; j >>= 1)
#pragma unroll
        for (int i = 0; i < 16; ++i) { const int l = i ^ j; if (l > i) ce_dp(v[A + i], p[A + i], v[A + l], p[A + l]); }
}
constexpr int PEER_L_CTAB = 148480, PEER_L_WSCR = 132096, PEER_L_RT = 0, PEER_L_SK = 32768, PEER_L_G2 = 98304, PEER_L_B2 = 106496, PEER_L_G1 = 114688, PEER_L_B1 = 122880;
__device__ __forceinline__ void peer_half_top16(LAS const unsigned char* sk_half  , const char* qbase  , unsigned qoff, int r32, int kh, unsigned (&k)[64]) {
    f32x16 acc[4];
#pragma unroll
    for (int mt = 0; mt < 4; ++mt) acc[mt] = (f32x16){0.f, 0.f, 0.f, 0.f, 0.f, 0.f, 0.f, 0.f, 0.f, 0.f, 0.f, 0.f, 0.f, 0.f, 0.f, 0.f};
    const unsigned rowb = (unsigned)r32 * 256u, sw = (unsigned)(r32 & 15);
    bf16x8 bq[8];
#pragma unroll
    for (int ks = 0; ks < 8; ++ks) bq[ks] = *(const bf16x8*)((qbase + qoff) + 32 * ks);
#pragma unroll
    for (int ks = 0; ks < 8; ++ks) {
        const bf16x8 b = bq[ks];
        const unsigned ch = (((unsigned)(2 * ks + kh)) ^ sw) << 4;
#pragma unroll
        for (int mt = 0; mt < 4; ++mt) {
            const bf16x8 a = *(LAS const bf16x8*)(sk_half + mt * 8192 + rowb + ch);
            acc[mt] = __builtin_amdgcn_mfma_f32_32x32x16_bf16(a, b, acc[mt], 0, 0, 0);
        }
    }
#pragma unroll
    for (int mt = 0; mt < 4; ++mt)
#pragma unroll
        for (int r = 0; r < 16; ++r) { const int key = 32 * mt + (r & 3) + 8 * (r >> 2);
            k[16 * mt + r] = (sortable(acc[mt][r]) & ~0x7Fu) | (unsigned)(127 - key - 4 * kh); }
    sort16_desc<0>(k); sort16_desc<16>(k); sort16_desc<32>(k); sort16_desc<48>(k);
    merge16_desc<0, 16>(k); merge16_desc<32, 48>(k); merge16_desc<0, 32>(k);
    unsigned lo[16], hi[16];
#pragma unroll
    for (int i = 0; i < 16; ++i) { auto rr = __builtin_amdgcn_permlane32_swap(k[i], k[i], false, false); lo[i] = rr[0]; hi[i] = rr[1]; }
#pragma unroll
    for (int i = 0; i < 16; ++i) k[i] = lo[i] > hi[15 - i] ? lo[i] : hi[15 - i];
#pragma unroll
    for (int j = 8; j > 0; j >>= 1)
#pragma unroll
        for (int i = 0; i < 16; ++i) { const int l = i ^ j; if (l > i) ce_d(k[i], k[l]); }
}
__device__ __forceinline__ constexpr int peer_cbase(int i) { int s = 0; for (int t = 0; t < i; ++t) s += 16 / (t + 1); return s; }

__device__ __forceinline__ void peer_topk_tile(const Frame& F, int m0, const bf16* qp, int* eidx, float* gate) {
    int lane; asm volatile("v_mbcnt_lo_u32_b32 %0, -1, 0\n\tv_mbcnt_hi_u32_b32 %0, -1, %0" : "=v"(lane));
    const int r32 = lane & 31, kh = lane >> 5, hd = F.wave;
    LAS const unsigned* ctab = (LAS const unsigned*)(F.lds + PEER_L_CTAB);
    LAS unsigned char* wscr = F.lds + PEER_L_WSCR + F.wave * 2048;
    const char* qbase = (const char*)(qp + (size_t)m0 * 2048 + hd * 256);
    const unsigned qoff = (unsigned)(r32 * 2048 + 8 * kh) * 2u;
    unsigned k1[64], k2[64];
    peer_half_top16(F.lds + PEER_L_SK, qbase, qoff, r32, kh, k1);
    __builtin_amdgcn_sched_barrier(0);
    peer_half_top16(F.lds + PEER_L_SK + 32768, qbase + 256, qoff, r32, kh, k2);
    __builtin_amdgcn_sched_barrier(0);
    float v1[16], v2[16];
#pragma unroll
    for (int i = 0; i < 16; ++i) { v1[i] = unsortable(k1[i] & ~0x7Fu); v2[i] = unsortable(k2[i] & ~0x7Fu);
        wscr[i * 64 + lane] = (unsigned char)(127u - (k1[i] & 0x7Fu)); wscr[(16 + i) * 64 + lane] = (unsigned char)(127u - (k2[i] & 0x7Fu)); }
    unsigned ck[64];
#pragma unroll
    for (int i = 0; i < 16; ++i)
#pragma unroll
        for (int j = 0; j < 16; ++j)
            if ((i + 1) * (j + 1) <= 16) { const int cid = peer_cbase(i) + j; ck[cid] = (sortable(v1[i] + v2[j]) & ~0x3Fu) | (unsigned)(63 - cid); }
#pragma unroll
    for (int c = 50; c < 64; ++c) ck[c] = 0u;
    __builtin_amdgcn_sched_barrier(0);
    sort16_desc<0>(ck); sort16_desc<16>(ck); sort16_desc<32>(ck); sort16_desc<48>(ck);
    merge16_desc<0, 16>(ck); merge16_desc<32, 48>(ck); merge16_desc<0, 32>(ck);
    float ex[16], es = 0.f; const float s0 = unsortable(ck[0] & ~0x3Fu);
    unsigned ee[16];
    asm volatile("s_waitcnt lgkmcnt(0)" ::: "memory");
#pragma unroll
    for (int i = 0; i < 16; ++i) { ex[i] = __builtin_amdgcn_exp2f((unsortable(ck[i] & ~0x3Fu) - s0) * LOG2E); es += ex[i];
        const unsigned ij = ctab[63u - (ck[i] & 0x3Fu)];
        ee[i] = (unsigned)wscr[(ij >> 4) * 64 + lane] * 128u + (unsigned)wscr[(16 + (ij & 15u)) * 64 + lane]; }
    const float inv = 1.f / es;
    if (kh == 0) {
        char* ep = (char*)(eidx + (size_t)m0 * 128 + hd * 16); char* gp = (char*)(gate + (size_t)m0 * 128 + hd * 16); const unsigned ro = (unsigned)r32 * 512u;
#pragma unroll
        for (int q = 0; q < 4; ++q) { *(v4u*)((ep + ro) + 16 * q) = (v4u){ee[4 * q], ee[4 * q + 1], ee[4 * q + 2], ee[4 * q + 3]};
            *(f32x4*)((gp + ro) + 16 * q) = (f32x4){ex[4 * q] * inv, ex[4 * q + 1] * inv, ex[4 * q + 2] * inv, ex[4 * q + 3] * inv}; }
    }
    asm volatile("s_waitcnt lgkmcnt(0)" ::: "memory");
}

__device__ __forceinline__ float wave_sum_dpp(float v) {
    v += __builtin_amdgcn_update_dpp(0.f, v, 0xB1, 0xf, 0xf, true);
    v += __builtin_amdgcn_update_dpp(0.f, v, 0x4E, 0xf, 0xf, true);
    v += __builtin_amdgcn_update_dpp(0.f, v, 0x141, 0xf, 0xf, true);
    v += __builtin_amdgcn_update_dpp(0.f, v, 0x140, 0xf, 0xf, true);
    v += __builtin_amdgcn_update_dpp(0.f, v, 0x142, 0xa, 0xf, false);
    v += __builtin_amdgcn_update_dpp(0.f, v, 0x143, 0xc, 0xf, false);
    return __builtin_bit_cast(float, __builtin_amdgcn_readlane(__builtin_bit_cast(int, v), 63));
}
__device__ __forceinline__ float gelu_exact(float x) { return 0.5f * x * (1.f + erff(x * 0.7071067811865476f)); }
__device__ __forceinline__ int rdlane_i(int v, int l) { return __builtin_amdgcn_readlane(v, l); }
__device__ __forceinline__ float rdlane_f(float v, int l) { return __builtin_bit_cast(float, __builtin_amdgcn_readlane(__builtin_bit_cast(int, v), l)); }

typedef __bf16 bf16x2_t __attribute__((ext_vector_type(2)));
__device__ __forceinline__ void peer_tokens(const Frame& F, int m0, int ntok, const bf16* zb, const float* stats, float* outp, const int* eidx, const float* gate, const unsigned char* uv4, const float* isu, const float* isv) {
    int lane; asm volatile("v_mbcnt_lo_u32_b32 %0, -1, 0\n\tv_mbcnt_hi_u32_b32 %0, -1, %0" : "=v"(lane));
    const unsigned l4 = (unsigned)lane * 4u, l128 = (unsigned)lane * 128u, l16 = (unsigned)lane * 16u;
    int e0, e1; float cf0, cf1, su0, su1;
    LAS unsigned char* rt = F.lds + (PEER_L_RT + F.wave * 4096);
    { unsigned o4_ = l16 >> 2; asm volatile("" : "+v"(o4_));
#pragma unroll 1
      for (int tk = 0; tk < ntok; ++tk) { const int mt = m0 + tk;
          const char* ebp_ = (const char*)(eidx + (size_t)mt * 128); const char* gbp_ = (const char*)(gate + (size_t)mt * 128);
          const int ea = *(const int*)(ebp_ + o4_), eb = *(const int*)((ebp_ + o4_) + 256);
          const float ca = *(const float*)(gbp_ + o4_) * isv[ea], cb = *(const float*)((gbp_ + o4_) + 256) * isv[eb], sa = isu[ea], sb = isu[eb];
          typedef unsigned v2u_ __attribute__((ext_vector_type(2)));
          *(LAS v2u_*)(rt + (tk * 1024 + o4_ * 2)) = (v2u_){(unsigned)ea | (f2bf(ca) << 16), __float_as_uint(sa)};
          *(LAS v2u_*)(rt + (tk * 1024 + 512 + o4_ * 2)) = (v2u_){(unsigned)eb | (f2bf(cb) << 16), __float_as_uint(sb)}; } }
#define PF_ROUTE_E(t_, ea_, eb_) do { typedef unsigned v2u_ __attribute__((ext_vector_type(2))); unsigned o8_ = l16 >> 1; asm volatile("" : "+v"(o8_)); \
        ea_ = (int)(*(LAS const unsigned*)(rt + ((t_) * 1024 + o8_)) & 0xFFFFu); eb_ = (int)(*(LAS const unsigned*)(rt + ((t_) * 1024 + 512 + o8_)) & 0xFFFFu); } while (0)
#define PF_ROUTE_F(t_) do { typedef unsigned v2u_ __attribute__((ext_vector_type(2))); unsigned o8_ = l16 >> 1; asm volatile("" : "+v"(o8_)); \
        const v2u_ ra_ = *(LAS const v2u_*)(rt + ((t_) * 1024 + o8_)), rb_ = *(LAS const v2u_*)(rt + ((t_) * 1024 + 512 + o8_)); \
        cf0 = __uint_as_float(ra_.x & 0xFFFF0000u); su0 = __uint_as_float(ra_.y); cf1 = __uint_as_float(rb_.x & 0xFFFF0000u); su1 = __uint_as_float(rb_.y); } while (0)
    PF_ROUTE_E(0, e0, e1); PF_ROUTE_F(0);
    v4u hv[4];
#define PF_HREC(m_) do { const int mh_ = (m_); const char* zrow = (const char*)(zb + (size_t)mh_ * 2048); \
    _Pragma("unroll") \
    for (int q = 0; q < 4; ++q) { unsigned l8 = l16 / 2; asm volatile("" : "+v"(l8)); const uint2 za = *(const uint2*)((zrow + l8) + 1024 * q), zb2 = *(const uint2*)((zrow + l8) + (1024 * q + 512)); \
        hv[q] = (v4u){za.x, za.y, zb2.x, zb2.y}; } \
    { float mean, rstd; pg8::ln1_row_stats(stats, mh_, mean, rstd); \
      unsigned gl_ = l16 + (unsigned)PEER_L_G2; asm volatile("" : "+v"(gl_)); LAS const unsigned char* gl = F.lds + gl_; \
    _Pragma("unroll") \
      for (int q = 0; q < 4; ++q) { const unsigned zx = hv[q].x, zy = hv[q].y, zz = hv[q].z, zw = hv[q].w; \
          const f32x4 ga = *(LAS const f32x4*)(gl + ((PEER_L_G1 - PEER_L_G2) + (2 * q) * 1024)), gb2 = *(LAS const f32x4*)(gl + ((PEER_L_G1 - PEER_L_G2) + (2 * q + 1) * 1024)); \
          const f32x4 ba = *(LAS const f32x4*)(gl + ((PEER_L_B1 - PEER_L_G2) + (2 * q) * 1024)), bb2 = *(LAS const f32x4*)(gl + ((PEER_L_B1 - PEER_L_G2) + (2 * q + 1) * 1024)); \
          v4u h; h.x = pk2((bflo(zx) - mean) * rstd * ga.x + ba.x, (bfhi(zx) - mean) * rstd * ga.y + ba.y); h.y = pk2((bflo(zy) - mean) * rstd * ga.z + ba.z, (bfhi(zy) - mean) * rstd * ga.w + ba.w); \
          h.z = pk2((bflo(zz) - mean) * rstd * gb2.x + bb2.x, (bfhi(zz) - mean) * rstd * gb2.y + bb2.y); h.w = pk2((bflo(zw) - mean) * rstd * gb2.z + bb2.z, (bfhi(zw) - mean) * rstd * gb2.w + bb2.w); \
          asm volatile("" : "+v"(h.x), "+v"(h.y), "+v"(h.z), "+v"(h.w)); \
          hv[q] = h; } } } while (0)
    PF_HREC(m0);
    __builtin_amdgcn_sched_barrier(0);
    f32x2 acc[16];
#pragma unroll
    for (int i = 0; i < 16; ++i) acc[i] = (f32x2){0.f, 0.f};
    v4u bu[16], bv[16];
#define PF_ROW(s_, j_) do { const int jj_ = (j_); const int e_ = (jj_ < 64) ? rdlane_i(e0, jj_ & 63) : rdlane_i(e1, jj_ & 63); \
        const unsigned char* rp_ = uv4 + (size_t)e_ * 2048; unsigned lo_ = l16; asm volatile("" : "+v"(lo_)); bu[s_] = *(const v4u*)(rp_ + lo_); bv[s_] = *(const v4u*)((rp_ + lo_) + 1024); } while (0)
#define PF_D4(w_, hq_) do { const unsigned hx_ = (hq_).x, hy_ = (hq_).y, hz_ = (hq_).z, hw_ = (hq_).w; \
        d_s = __builtin_amdgcn_fdot2_f32_bf16(__builtin_amdgcn_cvt_scalef32_pk_bf16_fp4((w_), 1.0f, 0), __builtin_bit_cast(bf16x2_t, hx_), d_s, false); \
        d_t = __builtin_amdgcn_fdot2_f32_bf16(__builtin_amdgcn_cvt_scalef32_pk_bf16_fp4((w_), 1.0f, 1), __builtin_bit_cast(bf16x2_t, hy_), d_t, false); \
        d_s = __builtin_amdgcn_fdot2_f32_bf16(__builtin_amdgcn_cvt_scalef32_pk_bf16_fp4((w_), 1.0f, 2), __builtin_bit_cast(bf16x2_t, hz_), d_s, false); \
        d_t = __builtin_amdgcn_fdot2_f32_bf16(__builtin_amdgcn_cvt_scalef32_pk_bf16_fp4((w_), 1.0f, 3), __builtin_bit_cast(bf16x2_t, hw_), d_t, false); } while (0)
#define PF_DOT(s_, dst_) do { float d_s = 0.f, d_t = 0.f; const unsigned wx_ = bu[s_].x, wy_ = bu[s_].y, wz_ = bu[s_].z, ww_ = bu[s_].w; \
        PF_D4(wx_, hv[0]); PF_D4(wy_, hv[1]); PF_D4(wz_, hv[2]); PF_D4(ww_, hv[3]); dst_ = wave_sum_dpp(d_s + d_t); } while (0)
#define PF_A4(w_, o_) do { \
        acc[(o_) + 0] += gg_ * __builtin_amdgcn_cvt_scalef32_pk_f32_fp4((w_), 1.0f, 0); acc[(o_) + 1] += gg_ * __builtin_amdgcn_cvt_scalef32_pk_f32_fp4((w_), 1.0f, 1); \
        acc[(o_) + 2] += gg_ * __builtin_amdgcn_cvt_scalef32_pk_f32_fp4((w_), 1.0f, 2); acc[(o_) + 3] += gg_ * __builtin_amdgcn_cvt_scalef32_pk_f32_fp4((w_), 1.0f, 3); } while (0)
#define PF_AXPY(s_, g_) do { const f32x2 gg_ = (f32x2){(g_), (g_)}; const unsigned wx_ = bv[s_].x, wy_ = bv[s_].y, wz_ = bv[s_].z, ww_ = bv[s_].w; \
        PF_A4(wx_, 0); PF_A4(wy_, 4); PF_A4(wz_, 8); PF_A4(ww_, 12); } while (0)
#define PF_BATCH(S0, j0_, jn_) do { const int j0v_ = (j0_); float av_ = 0.f; \
        _Pragma("unroll") for (int r_ = 0; r_ < 8; ++r_) { float d_; PF_DOT((S0) + r_, d_); if ((lane & 7) == r_) av_ = d_; } \
          \
        const int pj_ = j0v_ + (lane & 7); const int src_ = (pj_ & 63) << 2; \
        const float cfa_ = __builtin_bit_cast(float, __builtin_amdgcn_ds_bpermute(src_, __builtin_bit_cast(int, (j0v_ < 64) ? cf0 : cf1))); \
        const float sua_ = __builtin_bit_cast(float, __builtin_amdgcn_ds_bpermute(src_, __builtin_bit_cast(int, (j0v_ < 64) ? su0 : su1))); \
        const float gcv_ = cfa_ * gelu_exact(av_ * sua_); \
        _Pragma("unroll") for (int r_ = 0; r_ < 8; ++r_) { const float g_ = rdlane_f(gcv_, r_); PF_AXPY((S0) + r_, g_); if ((jn_) + r_ < 128) PF_ROW((S0) + r_, (jn_) + r_); } } while (0)
    int e0n = 0;
#define PF_ROWN(s_, j_) do { const int jj_ = (j_); const int e_ = rdlane_i(e0n, jj_ & 63); \
        const unsigned char* rp_ = uv4 + (size_t)e_ * 2048; unsigned lo_ = l16; asm volatile("" : "+v"(lo_)); bu[s_] = *(const v4u*)(rp_ + lo_); bv[s_] = *(const v4u*)((rp_ + lo_) + 1024); } while (0)
#define PF_BATCHX(S0, j0_, jn_, NR_) do { const int j0v_ = (j0_); float av_ = 0.f; \
        _Pragma("unroll") for (int r_ = 0; r_ < 8; ++r_) { float d_; PF_DOT((S0) + r_, d_); if ((lane & 7) == r_) av_ = d_; } \
        const int pj_ = j0v_ + (lane & 7); const int src_ = (pj_ & 63) << 2; \
        const float cfa_ = __builtin_bit_cast(float, __builtin_amdgcn_ds_bpermute(src_, __builtin_bit_cast(int, cf1))); \
        const float sua_ = __builtin_bit_cast(float, __builtin_amdgcn_ds_bpermute(src_, __builtin_bit_cast(int, su1))); \
        const float gcv_ = cfa_ * gelu_exact(av_ * sua_); \
        _Pragma("unroll") for (int r_ = 0; r_ < 8; ++r_) { const float g_ = rdlane_f(gcv_, r_); PF_AXPY((S0) + r_, g_); if (more && r_ < (NR_)) PF_ROWN((S0) + r_, (jn_) + r_); } } while (0)
#pragma unroll
    for (int r = 0; r < 16; ++r) PF_ROW(r, r);
#pragma unroll 1
    for (int t = 0; t < ntok; ++t) {
        const int m = m0 + t; const bool more = t + 1 < ntok;
#pragma unroll 1
        for (int jb = 0; jb < 112; jb += 16) { PF_BATCH(0, jb, jb + 16); PF_BATCH(8, jb + 8, jb + 24); }
        if (more) { unsigned o8_ = l16 >> 1; asm volatile("" : "+v"(o8_)); e0n = (int)(*(LAS const unsigned*)(rt + ((t + 1) * 1024 + o8_)) & 0xFFFFu); }
        PF_BATCHX(0, 112, 0, 8); PF_BATCHX(8, 120, 8, 4);
    __builtin_amdgcn_sched_barrier(0);
    float s = 0.f;
#pragma unroll
    for (int q = 0; q < 4; ++q) { const unsigned hx = hv[q].x, hy = hv[q].y, hz = hv[q].z, hw2 = hv[q].w;
        acc[4 * q + 0] = (f32x2){bflo(hx), bfhi(hx)} * ALPHA + acc[4 * q + 0]; acc[4 * q + 1] = (f32x2){bflo(hy), bfhi(hy)} * ALPHA + acc[4 * q + 1];
        acc[4 * q + 2] = (f32x2){bflo(hz), bfhi(hz)} * ALPHA + acc[4 * q + 2]; acc[4 * q + 3] = (f32x2){bflo(hw2), bfhi(hw2)} * ALPHA + acc[4 * q + 3];
        s += (acc[4 * q].x + acc[4 * q].y) + (acc[4 * q + 1].x + acc[4 * q + 1].y) + (acc[4 * q + 2].x + acc[4 * q + 2].y) + (acc[4 * q + 3].x + acc[4 * q + 3].y); }
    const float mean = wave_sum_dpp(s) * (1.f / 2048.f); float sq = 0.f;
#pragma unroll
    for (int i = 0; i < 16; ++i) { acc[i] = acc[i] - mean; sq += acc[i].x * acc[i].x + acc[i].y * acc[i].y; }
    const float rstd = 1.f / sqrtf(wave_sum_dpp(sq) * (1.f / 2048.f) + LN_EPS);
    char* orow = (char*)(outp + (size_t)m * 2048);
    unsigned lg2_; asm volatile("v_add_u32 %0, %1, %2" : "=v"(lg2_) : "v"(l16), "v"((unsigned)PEER_L_G2));
#pragma unroll
    for (int q = 0; q < 8; ++q) { const int eo = 16 * q;
        const f32x4 gg = *(LAS const f32x4*)((F.lds + lg2_) + q * 1024), bb = *(LAS const f32x4*)((F.lds + lg2_) + ((PEER_L_B2 - PEER_L_G2) + q * 1024));
        f32x4 o; o.x = acc[2 * q].x * rstd * gg.x + bb.x; o.y = acc[2 * q].y * rstd * gg.y + bb.y; o.z = acc[2 * q + 1].x * rstd * gg.z + bb.z; o.w = acc[2 * q + 1].y * rstd * gg.w + bb.w;
        unsigned o16_ = l16; asm volatile("" : "+v"(o16_)); *(f32x4*)((orow + o16_) + 1024 * q) = o; }
        __builtin_amdgcn_sched_barrier(0);
        if (more) { PF_ROUTE_E(t + 1, e0, e1);
#pragma unroll
            for (int r = 4; r < 8; ++r) PF_ROW(8 + r, 8 + r);
            PF_ROUTE_F(t + 1); PF_HREC(m + 1);
#pragma unroll
            for (int i = 0; i < 16; ++i) acc[i] = (f32x2){0.f, 0.f}; }
    }
#undef PF_ROW
#undef PF_ROWN
#undef PF_BATCHX
#undef PF_ROUTE_E
#undef PF_ROUTE_F
#undef PF_HREC
#undef PF_D4
#undef PF_DOT
#undef PF_A4
#undef PF_AXPY
#undef PF_BATCH
}

__device__ __forceinline__ void phase_peer_fast(const Frame& F, float* outp, const bf16* zb, const float* stats, const bf16* qp, const bf16* skb, int* eidx, float* gate,
                                                const unsigned char* uv4, const float* isu, const float* isv, const float* g2, const float* b2, const float* g1, const float* b1) {
    if (F.tid < 64) { unsigned v = 0u; int cid = 0;
        for (int i = 0; i < 16; ++i) for (int j = 0; j < 16; ++j) if ((i + 1) * (j + 1) <= 16) { if (cid == F.tid) v = (unsigned)(i * 16 + j); ++cid; }
        ((LAS unsigned*)(F.lds + PEER_L_CTAB))[F.tid] = v; }
    for (int c = F.tid; c < 2 * 128 * 16; c += NTHREADS) {
        const int row = c >> 4, ch = c & 15;
        const v4u w = *(const v4u*)(skb + (size_t)row * 128 + ch * 8);
        *(LAS v4u*)(F.lds + PEER_L_SK + row * 256 + ((ch ^ (row & 15)) << 4)) = w;
    }
    for (int c = F.tid; c < 512; c += NTHREADS) { const int src = 4 * c;
        *(LAS f32x4*)(F.lds + PEER_L_G2 + c * 16) = *(const f32x4*)(g2 + src); *(LAS f32x4*)(F.lds + PEER_L_B2 + c * 16) = *(const f32x4*)(b2 + src);
        *(LAS f32x4*)(F.lds + PEER_L_G1 + c * 16) = *(const f32x4*)(g1 + src); *(LAS f32x4*)(F.lds + PEER_L_B1 + c * 16) = *(const f32x4*)(b1 + src); }
    __syncthreads();
    const bool tilewise = (F.vcu & 1) != 0;
#pragma unroll 1
    for (int t0 = F.vcu; t0 < M_TOK / 32; t0 += (tilewise ? F.G : M_TOK)) {
#pragma unroll 1
        for (int tile = t0; tile < M_TOK / 32; tile += F.G) { peer_topk_tile(F, tile * 32, qp, eidx, gate); if (tilewise) break; }
        asm volatile("s_waitcnt vmcnt(0)" ::: "memory");
        __syncthreads();
        __builtin_amdgcn_sched_barrier(0);
#pragma unroll 1
        for (int tile = t0; tile < M_TOK / 32; tile += F.G) {
            peer_tokens(F, tile * 32 + F.wave * 4, 4, zb, stats, outp, eidx, gate, uv4, isu, isv);
            if (tilewise) break;
        }
    }
}

__device__ __forceinline__ float wave_max_dpp(float v) {
    v = fmaxf(v, __builtin_amdgcn_update_dpp(v, v, 0xB1, 0xf, 0xf, false));
    v = fmaxf(v, __builtin_amdgcn_update_dpp(v, v, 0x4E, 0xf, 0xf, false));
    v = fmaxf(v, __builtin_amdgcn_update_dpp(v, v, 0x141, 0xf, 0xf, false));
    v = fmaxf(v, __builtin_amdgcn_update_dpp(v, v, 0x140, 0xf, 0xf, false));
    v = fmaxf(v, __builtin_amdgcn_update_dpp(v, v, 0x142, 0xa, 0xf, false));
    v = fmaxf(v, __builtin_amdgcn_update_dpp(v, v, 0x143, 0xc, 0xf, false));
    return __builtin_bit_cast(float, __builtin_amdgcn_readlane(__builtin_bit_cast(int, v), 63));
}
__device__ __forceinline__ void cvt_rows_fp4(const Frame& F, const float* tab, unsigned char* t4  , float* inv_scale, int row_begin, int row_end, int widx, int nwork) {
    const int lane = F.lane; const int NGW = nwork * NWAVES;
    const int row0 = row_begin + widx * NWAVES + F.wave;
    f32x4 rg[4][8];
#define CV_LOAD(slot_, row_) do { const int rr_ = (row_); if (rr_ < row_end) { const f32x4* rp_ = (const f32x4*)(tab + (size_t)rr_ * 2048 + 4 * lane);        \
        _Pragma("unroll") for (int j = 0; j < 8; ++j) rg[slot_][j] = rp_[64 * j]; } } while (0)
#define CV_ROW(slot_, row_) do { const int rr_ = (row_); float am = 0.f; \
        _Pragma("unroll") for (int j = 0; j < 8; ++j) am = fmaxf(am, fmaxf(fmaxf(fabsf(rg[slot_][j].x), fabsf(rg[slot_][j].y)), fmaxf(fabsf(rg[slot_][j].z), fabsf(rg[slot_][j].w)))); \
        am = wave_max_dpp(am); const float sc = am > 0.f ? 6.f / am : 0.f; \
        if (lane == 0) inv_scale[rr_] = am > 0.f ? am / 6.f : 0.f; \
        v4u o; \
        _Pragma("unroll") for (int d = 0; d < 4; ++d) { unsigned w = 0u; \
            w = __builtin_amdgcn_cvt_scalef32_pk_fp4_f32(w, rg[slot_][2 * d].x * sc, rg[slot_][2 * d].y * sc, 1.0f, 0); w = __builtin_amdgcn_cvt_scalef32_pk_fp4_f32(w, rg[slot_][2 * d].z * sc, rg[slot_][2 * d].w * sc, 1.0f, 1); \
            w = __builtin_amdgcn_cvt_scalef32_pk_fp4_f32(w, rg[slot_][2 * d + 1].x * sc, rg[slot_][2 * d + 1].y * sc, 1.0f, 2); w = __builtin_amdgcn_cvt_scalef32_pk_fp4_f32(w, rg[slot_][2 * d + 1].z * sc, rg[slot_][2 * d + 1].w * sc, 1.0f, 3); \
            if (d == 0) o.x = w; else if (d == 1) o.y = w; else if (d == 2) o.z = w; else o.w = w; } \
        *(v4u*)(t4 + (size_t)rr_ * 2048 + 16 * lane) = o; } while (0)
    CV_LOAD(0, row0); CV_LOAD(1, row0 + NGW); CV_LOAD(2, row0 + 2 * NGW);
#pragma unroll 1
    for (int row = row0; row < row_end; row += 4 * NGW) {
        CV_LOAD(3, row + 3 * NGW); CV_ROW(0, row);
        if (row + NGW < row_end) { CV_LOAD(0, row + 4 * NGW); CV_ROW(1, row + NGW); }
        if (row + 2 * NGW < row_end) { CV_LOAD(1, row + 5 * NGW); CV_ROW(2, row + 2 * NGW); }
        if (row + 3 * NGW < row_end) { CV_LOAD(2, row + 6 * NGW); CV_ROW(3, row + 3 * NGW); }
    }
#undef CV_LOAD
#undef CV_ROW
}

namespace att {
constexpr int D = 128, PITCH = 1024, OPITCH = 2048;
constexpr int NW = 8, QBLK = 32, KVBLK = 64, QB = NW * QBLK;
constexpr int SHM_V = KVBLK * D * 2, SHM_K = KVBLK * D * 2;
constexpr int LDS_ATT_BYTES = 2 * SHM_V + 2 * SHM_K + NW * 64 * 4;
constexpr int LDS_BIAS_OFF = 69632;
constexpr float THR2 = 11.5f;
constexpr bool WSKIP = false;

typedef short bf16x8 __attribute__((ext_vector_type(8)));
typedef short s16x4 __attribute__((ext_vector_type(4)));
typedef float f32x16 __attribute__((ext_vector_type(16)));
typedef float f32x4 __attribute__((ext_vector_type(4)));
typedef unsigned u32x4 __attribute__((ext_vector_type(4)));
template <class A, class Bt> struct same_t { static constexpr bool v = false; };
template <class A> struct same_t<A, A> { static constexpr bool v = true; };

#define KSWZ(row, colB) ((row) * 256 + ((colB) ^ (((row) & 7) << 4)))
#define SBAR() __builtin_amdgcn_sched_barrier(0)
__device__ __forceinline__ int v_st(int k, int c) { const int kk = (k & ~0xC) | ((k & 4) << 1) | ((k & 8) >> 1); return ((kk >> 3) * 4 + (c >> 5)) * 512 + ((kk & 7) * 32 + (c & 31)) * 2; }
__device__ __forceinline__ int v_rd_base(int lane) { return ((lane & 3) << 3) | (((lane >> 2) & 3) << 6) | (((lane >> 4) & 1) << 5) | (((lane >> 5) & 1) << 8); }
constexpr int v_rd_off(int d0, int ks, int half) { return d0 * 512 + ks * 4096 + half * 2048; }
__device__ __forceinline__ int crow(int r, int hi) { return (r & 3) + 8 * (r >> 2) + 4 * hi; }
__device__ __forceinline__ unsigned cvtpk(float lo, float hi) {
    unsigned r; asm volatile("v_cvt_pk_bf16_f32 %0, %1, %2" : "=v"(r) : "v"(lo), "v"(hi)); return r;
}
__device__ __forceinline__ bf16x8 pack8(f32x4 a, f32x4 b) {
    u32x4 w = {cvtpk(a[0], a[1]), cvtpk(a[2], a[3]), cvtpk(b[0], b[1]), cvtpk(b[2], b[3])};
    return *reinterpret_cast<bf16x8*>(&w);
}
template <class T> __device__ __forceinline__ bf16x8 load8(const T* p) {
    if constexpr (same_t<T, float>::v) { return pack8(*(const f32x4*)p, *(const f32x4*)(p + 4)); }
    else { return *reinterpret_cast<const bf16x8*>(p); }
}
__device__ __forceinline__ void mask_tile(f32x16& p0, f32x16& p1, int dq, unsigned W) {
    const float NEG = -__builtin_inff();
#pragma unroll
    for (int r = 0; r < 16; ++r) {
        const int c = (r & 3) + 8 * (r >> 2);
        if ((unsigned)(dq - c) >= W) p0[r] = NEG;
        if ((unsigned)(dq - c - 32) >= W) p1[r] = NEG;
    }
}
__device__ __forceinline__ void partialSM(f32x16& p0, f32x16& p1, float& m_reg, float& mn, float& alpha) {
    float pmax = p0[0]; for (int r = 1; r < 16; ++r) pmax = fmaxf(pmax, p0[r]); for (int r = 0; r < 16; ++r) pmax = fmaxf(pmax, p1[r]);
    { auto rr = __builtin_amdgcn_permlane32_swap(__float_as_uint(pmax), __float_as_uint(pmax), false, false);
      pmax = fmaxf(__uint_as_float(rr[0]), __uint_as_float(rr[1])); }
    if (__builtin_expect(__all((pmax - m_reg) <= THR2), 1)) { mn = m_reg; alpha = 1.f; }
    else { mn = fmaxf(m_reg, pmax); alpha = __builtin_amdgcn_exp2f(m_reg - mn); m_reg = mn; }
    for (int r = 0; r < 16; ++r) p0[r] = p0[r] - mn; for (int r = 0; r < 16; ++r) p1[r] = p1[r] - mn;
    for (int r = 0; r < 16; ++r) p0[r] = __builtin_amdgcn_exp2f(p0[r]);
}
__device__ __forceinline__ void finishSM(f32x16& p0, f32x16& p1, float alpha, float& l_reg, bf16x8& pa0, bf16x8& pa1, bf16x8& pa2, bf16x8& pa3) {
    for (int r = 0; r < 16; ++r) p1[r] = __builtin_amdgcn_exp2f(p1[r]);
    float ps = 0; for (int r = 0; r < 16; ++r) ps += p0[r]; for (int r = 0; r < 16; ++r) ps += p1[r];
    { auto rr = __builtin_amdgcn_permlane32_swap(__float_as_uint(ps), __float_as_uint(ps), false, false);
      ps = __uint_as_float(rr[0]) + __uint_as_float(rr[1]); }
    l_reg = l_reg * alpha + ps;
#define PK4(P, B_, OUT) do { unsigned a0 = cvtpk(P[B_+0], P[B_+1]), a1 = cvtpk(P[B_+2], P[B_+3]);                          \
        unsigned b0 = cvtpk(P[B_+4], P[B_+5]), b1 = cvtpk(P[B_+6], P[B_+7]);                                             \
        auto r0 = __builtin_amdgcn_permlane32_swap(a0, b0, false, false); auto r1 = __builtin_amdgcn_permlane32_swap(a1, b1, false, false); \
        u32x4 w = {r0[0], r1[0], r0[1], r1[1]}; OUT = *reinterpret_cast<bf16x8*>(&w); } while (0)
    PK4(p0, 0, pa0); PK4(p0, 8, pa1); PK4(p1, 0, pa2); PK4(p1, 8, pa3);
#undef PK4
}
template <int KB, bool SK>
__device__ __forceinline__ void qkt(f32x16& p0, f32x16& p1, const char* K_lds, int r32, int hi, const bf16x8* qr, bool act) {
    if (SK && !act) { const float NEG = -__builtin_inff();
#pragma unroll
        for (int r = 0; r < 16; ++r) { p0[r] = NEG; p1[r] = NEG; } return; }
    p0 = f32x16{}; p1 = f32x16{};
    const char* kb[4];
#pragma unroll
    for (int dd = 0; dd < 4; ++dd) kb[dd] = K_lds + KB * SHM_K + KSWZ(r32, (dd * 16 + hi * 8) * 2);
#pragma unroll
    for (int d0 = 0; d0 < 8; ++d0) { const char* a = kb[d0 & 3] + (d0 >> 2) * 128;
        bf16x8 b0 = *reinterpret_cast<const bf16x8*>(a);
        bf16x8 b1 = *reinterpret_cast<const bf16x8*>(a + 32 * 256);
        p0 = __builtin_amdgcn_mfma_f32_32x32x16_bf16(b0, qr[d0], p0, 0, 0, 0);
        p1 = __builtin_amdgcn_mfma_f32_32x32x16_bf16(b1, qr[d0], p1, 0, 0, 0); }
}
template <int VB, bool SK>
__device__ __forceinline__ void pv_tile(f32x16* o, int vb0, bf16x8 pa0, bf16x8 pa1, bf16x8 pa2, bf16x8 pa3, bool act) {
    if (SK && !act) return;
#define TRRD(dst, off) asm volatile("ds_read_b64_tr_b16 %0, %1 offset:%2" : "=&v"(dst) : "v"(vb0), "i"(off) : "memory")
#define PV_D0(d0) do { s16x4 l0, l1, l2, l3, h0, h1, h2, h3; constexpr int b_ = VB * SHM_V + v_rd_off(d0, 0, 0);     \
        TRRD(l0, b_); TRRD(h0, b_ + 2048); TRRD(l1, b_ + 4096); TRRD(h1, b_ + 6144); TRRD(l2, b_ + 8192); TRRD(h2, b_ + 10240); TRRD(l3, b_ + 12288); TRRD(h3, b_ + 14336); \
        asm volatile("s_waitcnt lgkmcnt(0)" ::: "memory"); SBAR();                 \
        o[d0] = __builtin_amdgcn_mfma_f32_32x32x16_bf16(pa0, (bf16x8){l0[0], l0[1], l0[2], l0[3], h0[0], h0[1], h0[2], h0[3]}, o[d0], 0, 0, 0);   \
        o[d0] = __builtin_amdgcn_mfma_f32_32x32x16_bf16(pa1, (bf16x8){l1[0], l1[1], l1[2], l1[3], h1[0], h1[1], h1[2], h1[3]}, o[d0], 0, 0, 0);   \
        o[d0] = __builtin_amdgcn_mfma_f32_32x32x16_bf16(pa2, (bf16x8){l2[0], l2[1], l2[2], l2[3], h2[0], h2[1], h2[2], h2[3]}, o[d0], 0, 0, 0);   \
        o[d0] = __builtin_amdgcn_mfma_f32_32x32x16_bf16(pa3, (bf16x8){l3[0], l3[1], l3[2], l3[3], h3[0], h3[1], h3[2], h3[3]}, o[d0], 0, 0, 0); } while (0)
    PV_D0(0); PV_D0(1); PV_D0(2); PV_D0(3);
#undef PV_D0
#undef TRRD
}

typedef unsigned u32x2 __attribute__((ext_vector_type(2)));
__device__ __forceinline__ void sel_tile(f32x16& p0, f32x16& p1, u32x2 mw, int hi) {
    const unsigned w0 = mw.x >> (4 * hi), w1 = mw.y >> (4 * hi);
#pragma unroll
    for (int r = 0; r < 16; ++r) {
        const int c = (r & 3) + 8 * (r >> 2);
        const unsigned m0 = (unsigned)__builtin_amdgcn_sbfe((int)w0, c, 1), m1 = (unsigned)__builtin_amdgcn_sbfe((int)w1, c, 1);
        const float x0 = p0[r], x1 = p1[r];
        p0[r] = __uint_as_float((__float_as_uint(x0) & m0) | (0xFF800000u & ~m0));
        p1[r] = __uint_as_float((__float_as_uint(x1) & m1) | (0xFF800000u & ~m1));
    }
}
__device__ __forceinline__ void bias_tile(f32x16& p0, f32x16& p1, int dq, const float* btab) {
#pragma unroll
    for (int r = 0; r < 16; ++r) {
        const int c = (r & 3) + 8 * (r >> 2);
        const unsigned i0 = (unsigned)(dq - c), i1 = (unsigned)(dq - c - 32);
        p0[r] += btab[i0 < 128u ? i0 : 128u]; p1[r] += btab[i1 < 128u ? i1 : 128u];
    }
}
template <class TIn, class TOut> struct BlockRef { const TIn* Q; const TIn* K; const TIn* V; TOut* O; int P0; const unsigned* MR; int head; };
template <class TIn> struct Seam {
    bf16x8 qr[8];
    bf16x8 st_v0, st_v1, st_k0, st_k1; f32x4 sf0, sf1, sf2, sf3;
    f32x4 tq[16];
};
__device__ __forceinline__ int swa_jlo(int P0, int W) { const int lowk = P0 - W + 1; return lowk > 0 ? lowk / KVBLK : 0; }
#define ROW(p, k0, rr) ((p) + (size_t)((k0) + (rr)) * PITCH + sc)
#define VMW() asm volatile("s_waitcnt vmcnt(0)" ::: "memory")
#define VMWN(n) asm volatile("s_waitcnt vmcnt(%0)" :: "i"(n) : "memory")
#define ROWB(p, k0, ro) ((const TIn*)(((const char*)((p) + (size_t)(k0) * PITCH)) + (ro)))
#define SLOAD_H(Kp, Vp, k0) do { S.st_v0 = load8<TIn>(ROWB(Vp, k0, roff0)); S.st_v1 = load8<TIn>(ROWB(Vp, k0, roff1));              \
                         S.st_k0 = load8<TIn>(ROWB(Kp, k0, roff0)); S.st_k1 = load8<TIn>(ROWB(Kp, k0, roff1)); } while (0)
#define SWRITE_HK(bf) do { *(bf16x8*)(K_lds + (bf) * SHM_K + kws) = S.st_k0; *(bf16x8*)(K_lds + (bf) * SHM_K + kws + 32 * 256) = S.st_k1; } while (0)
#define SWRITE_HV(bf) do { *(bf16x8*)(V_lds + (bf) * SHM_V + vst0) = S.st_v0; *(bf16x8*)(V_lds + (bf) * SHM_V + vst1) = S.st_v1; } while (0)
#define SWRITE_H(bf) do { SWRITE_HV(bf); SWRITE_HK(bf); } while (0)
#define SLOAD_F(p, k0) do { S.sf0 = *(const f32x4*)ROW(p, k0, sr); S.sf1 = *(const f32x4*)(ROW(p, k0, sr) + 4);                \
                            S.sf2 = *(const f32x4*)ROW(p, k0, 32 + sr); S.sf3 = *(const f32x4*)(ROW(p, k0, 32 + sr) + 4); } while (0)
#define SWRITE_KF(bf) do { *(bf16x8*)(K_lds + (bf) * SHM_K + kws) = pack8(S.sf0, S.sf1); *(bf16x8*)(K_lds + (bf) * SHM_K + kws + 32 * 256) = pack8(S.sf2, S.sf3); } while (0)
#define SWRITE_VF(bf) do { *(bf16x8*)(V_lds + (bf) * SHM_V + vst0) = pack8(S.sf0, S.sf1); *(bf16x8*)(V_lds + (bf) * SHM_V + vst1) = pack8(S.sf2, S.sf3); } while (0)
template <class TIn, class TOut>
__device__ __forceinline__ void causal_swa_prime(const BlockRef<TIn, TOut>& cur, int W, char* lds, Seam<TIn>& S, const int tid_in) {
    constexpr bool F32 = same_t<TIn, float>::v;
    const int tid = tid_in, wid = __builtin_amdgcn_readfirstlane(tid >> 6), lane = tid & 63, r32 = lane & 31, hi = lane >> 5;
    const int sr = tid >> 4, sc = (tid & 15) * 8, kws = KSWZ(sr, sc * 2); char* K_lds = lds + 2 * SHM_V;
    const unsigned roff0 = (unsigned)(sr * PITCH + sc) * 2u, roff1 = roff0 + 32u * PITCH * 2u;
    const int kb0 = swa_jlo(cur.P0, W) * KVBLK;
    { const char* qb_ = (const char*)(cur.Q + (size_t)(wid * QBLK) * PITCH); const unsigned qo_ = (unsigned)(r32 * PITCH + hi * 8) * 2u;
      for (int d0 = 0; d0 < 8; ++d0) S.qr[d0] = *(const bf16x8*)((qb_ + qo_) + d0 * 32); }
    if constexpr (F32) { SLOAD_F((const float*)cur.K, kb0); VMW(); SWRITE_KF(0); SBAR(); SLOAD_F((const float*)cur.V, kb0); }
    else { SLOAD_H(cur.K, cur.V, kb0); VMW(); SWRITE_HK(0); }
    __syncthreads();
}
template <class TIn, class TOut>
__device__ __forceinline__ void causal_swa_block(const BlockRef<TIn, TOut>& cur, const BlockRef<TIn, TOut>& nxt, int skv, int W, char* lds, Seam<TIn>& S, const int tid_in) {
    constexpr bool F32 = same_t<TIn, float>::v;
    const int tid = tid_in, wid = __builtin_amdgcn_readfirstlane(tid >> 6), lane = tid & 63, r32 = lane & 31, hi = lane >> 5;
    const int j_lo = swa_jlo(cur.P0, W);
    int j_hi = (cur.P0 + QB - 1) / KVBLK + 1; if (j_hi > skv / KVBLK) j_hi = skv / KVBLK;
    const int NT = j_hi - j_lo;
    const int kbn = swa_jlo(nxt.P0, W) * KVBLK;
    const int qlo = cur.P0 + wid * QBLK, qm = qlo + r32 - 4 * hi;
    char* V_lds = lds; char* K_lds = lds + 2 * SHM_V;
    float* ws = (float*)(lds + 2 * SHM_V + 2 * SHM_K) + wid * 64; float* li_l = ws, * al_l = ws + 32;
    float m_reg = -1e30f, l_reg = 0; f32x16 o[4] = {};
    const int sr = tid >> 4, sc = (tid & 15) * 8, vst0 = v_st(sr, sc), vst1 = v_st(32 + sr, sc), kws = KSWZ(sr, sc * 2);
    const unsigned roff0 = (unsigned)(sr * PITCH + sc) * 2u, roff1 = roff0 + 32u * PITCH * 2u;
    const int vb0 = (int)(uintptr_t)V_lds + v_rd_base(lane);
    const TIn* Kh = cur.K; const TIn* Vh = cur.V;
    const unsigned mrow_off = (unsigned)(wid * QBLK + r32) * 512u; u32x2 mw = (u32x2){0u, 0u};
    const float* btab = (const float*)(lds + LDS_BIAS_OFF) + cur.head * 132;
#define RESC(a) do { if (__any((a) < 1.f)) { if (hi == 0) al_l[r32] = (a); asm volatile("s_waitcnt lgkmcnt(0)" ::: "memory");              \
                     for (int d_ = 0; d_ < 4; ++d_) for (int r = 0; r < 16; ++r) o[d_][r] *= al_l[crow(r, hi)]; } } while (0)
#define KBASE(t) ((j_lo + (t)) * KVBLK)
#define ACT(t) (KBASE(t) <= qlo + QBLK - 1 && KBASE(t) + KVBLK - 1 >= qlo - W + 1)
#define MASKT(P0_, P1_, t) do { const int kb_ = KBASE(t); if (kb_ <= qlo + QBLK - 1 && kb_ + KVBLK - 1 >= qlo - 127) bias_tile(P0_, P1_, qm - kb_, btab); sel_tile(P0_, P1_, mw, hi); } while (0)
#define MWLOAD(t) do { const char* mb_ = (const char*)cur.MR + 8 * (j_lo + (t)); mw = *(const u32x2*)(mb_ + mrow_off); } while (0)
    constexpr int NQL = F32 ? 16 : 8;
    constexpr bool SK = WSKIP && !F32;
#define SEAM_K0() do { VMWN(NQL); if constexpr (F32) { SWRITE_KF(0); SBAR(); SLOAD_F((const float*)nxt.V, kbn); } else { SWRITE_HK(0); } SBAR(); } while (0)
    f32x16 pA0, pA1, pB0, pB1; float mnA, mnB, alA, alB; bf16x8 pa0, pa1, pa2, pa3;
    if constexpr (F32) { VMW(); SWRITE_VF(0); SBAR(); } else { SWRITE_HV(0); SBAR(); }
    if (NT > 1) { if constexpr (F32) SLOAD_F((const float*)Kh, KBASE(1)); else SLOAD_H(Kh, Vh, KBASE(1)); }
    MWLOAD(0); SBAR(); qkt<0, SK>(pA0, pA1, K_lds, r32, hi, S.qr, ACT(0));
    if constexpr (F32) { if (NT > 1) { VMW(); SWRITE_KF(1); SBAR(); SLOAD_F((const float*)Vh, KBASE(1)); } }
    MASKT(pA0, pA1, 0); partialSM(pA0, pA1, m_reg, mnA, alA);
    if (NT > 1) { VMW(); if constexpr (F32) { SWRITE_VF(1); SBAR(); if (NT > 2) SLOAD_F((const float*)Kh, KBASE(2)); } else SWRITE_H(1); }
    __syncthreads();
#define HALF_STEP(PX0, PX1, mnX, alX, PY0, PY1, alY, t, KB, VB, SB) do {                                                      \
        MWLOAD(t); SBAR(); qkt<KB, SK>(PX0, PX1, K_lds, r32, hi, S.qr, ACT(t));                                             \
        finishSM(PY0, PY1, alY, l_reg, pa0, pa1, pa2, pa3); SBAR();                                                           \
        if ((t) + 1 < NT) { if constexpr (F32) { VMW(); SWRITE_KF(SB); SBAR(); SLOAD_F((const float*)Vh, KBASE((t) + 1)); }  \
                            else { SLOAD_H(Kh, Vh, KBASE((t) + 1)); } SBAR(); }                                               \
        pv_tile<VB, SK>(o, vb0, pa0, pa1, pa2, pa3, ACT((t) - 1)); MASKT(PX0, PX1, (t)); partialSM(PX0, PX1, m_reg, mnX, alX);                                        \
        __syncthreads();                                                                                                      \
        if ((t) + 1 < NT) { VMW(); if constexpr (F32) { SWRITE_VF(SB); SBAR(); if ((t) + 2 < NT) SLOAD_F((const float*)Kh, KBASE((t) + 2)); } \
                            else { SWRITE_H(SB); } }                                                                          \
        RESC(alX); __syncthreads(); } while (0)
    for (int t = 1; t + 1 < NT; t += 2) {
        HALF_STEP(pB0, pB1, mnB, alB, pA0, pA1, alA, t, 1, 0, 0);
        HALF_STEP(pA0, pA1, mnA, alA, pB0, pB1, alB, t + 1, 0, 1, 1);
    }
    const bool even = (NT & 1) == 0;
    if (even) { MWLOAD(NT - 1); SBAR(); qkt<1, SK>(pB0, pB1, K_lds, r32, hi, S.qr, ACT(NT - 1)); SBAR(); }
#define QROW(e) (nxt.Q + (size_t)(wid * QBLK + r32) * PITCH + ((e) >> 1) * 16 + hi * 8 + ((e) & 1) * 4)
    if constexpr (F32) { SLOAD_F((const float*)nxt.K, kbn); SBAR();
#pragma unroll
        for (int e = 0; e < 8; ++e) S.tq[e] = *(const f32x4*)QROW(e); }
    else { SLOAD_H(nxt.K, nxt.V, kbn); SBAR();
        { const char* qb_ = (const char*)(nxt.Q + (size_t)(wid * QBLK) * PITCH); const unsigned qo_ = (unsigned)(r32 * PITCH + hi * 8) * 2u;
_Pragma("unroll")
          for (int d0 = 0; d0 < 8; ++d0) S.qr[d0] = *(const bf16x8*)((qb_ + qo_) + d0 * 32); } }
    SBAR();
    finishSM(pA0, pA1, alA, l_reg, pa0, pa1, pa2, pa3); SBAR();
    if constexpr (F32) {
#pragma unroll
        for (int e = 8; e < 16; ++e) S.tq[e] = *(const f32x4*)QROW(e); SBAR(); }
#undef QROW
    pv_tile<0, SK>(o, vb0, pa0, pa1, pa2, pa3, ACT(even ? NT - 2 : NT - 1));
    if (even) { MASKT(pB0, pB1, NT - 1); partialSM(pB0, pB1, m_reg, mnB, alB); __syncthreads(); RESC(alB);
        finishSM(pB0, pB1, alB, l_reg, pa0, pa1, pa2, pa3); SBAR(); pv_tile<1, SK>(o, vb0, pa0, pa1, pa2, pa3, ACT(NT - 1)); }
    SBAR(); SEAM_K0();
    if (hi == 0) li_l[r32] = l_reg; asm volatile("s_waitcnt lgkmcnt(0)" ::: "memory");
    float rli[16];
#pragma unroll
    for (int r = 0; r < 16; ++r) rli[r] = __builtin_amdgcn_rcpf(li_l[crow(r, hi)]);
    char* Ow = (char*)(cur.O + (size_t)(wid * QBLK) * OPITCH); const unsigned oo_ = (unsigned)(4 * hi * OPITCH + r32) * 2u;
#pragma unroll
    for (int r = 0; r < 16; ++r) { const int orow0 = (r & 3) + 8 * (r >> 2);
#pragma unroll
        for (int d0 = 0; d0 < 4; ++d0) { const float v = o[d0][r] * rli[r];
            if constexpr (same_t<TOut, float>::v) { }
            else { const float vn = __shfl_xor(v, 1);
                   if ((r32 & 1) == 0) *(unsigned*)((Ow + oo_) + (orow0 * OPITCH + d0 * 32) * 2) = cvtpk(v, vn); } } }
    if constexpr (F32) {
#pragma unroll
        for (int d0 = 0; d0 < 8; ++d0) S.qr[d0] = pack8(S.tq[2 * d0], S.tq[2 * d0 + 1]); }
    __syncthreads();
#undef RESC
#undef KBASE
#undef ACT
#undef MASKT
#undef MWLOAD
#undef SEAM_K0
#undef HALF_STEP
}
#undef ROW
#undef VMW
#undef VMWN
#undef SLOAD_H
#undef ROWB
#undef SWRITE_HK
#undef SWRITE_HV
#undef SWRITE_H
#undef SLOAD_F
#undef SWRITE_KF
#undef SWRITE_VF
}

__device__ __forceinline__ att::BlockRef<bf16, bf16> attn_ref(int bh, int qb, const bf16* Q, const bf16* K, const bf16* V, const unsigned* mask, bf16* mixin) {
    const int b = bh >> 3, h = bh & 7; att::BlockRef<bf16, bf16> r;
    const size_t row0 = (size_t)b * SEQ + (size_t)qb * att::QB;
    r.Q = Q + row0 * 1024 + h * 128; r.K = K + (size_t)b * SEQ * 1024 + h * 128; r.V = V + (size_t)b * SEQ * 1024 + h * 128;
    r.O = mixin + row0 * 2048 + 1024 + h * 128; r.P0 = qb * att::QB; r.MR = mask + row0 * 128; r.head = h;
    return r;
}
__device__ __forceinline__ void phase_attn_fast(const Frame& F, const bf16* Q, const bf16* K, const bf16* V, const unsigned* mask, const float* rel_bias, bf16* mixin) {
    char* lds = (char*)F.ldsg;
    float* bt = (float*)(lds + att::LDS_BIAS_OFF);
    for (int i = F.tid; i < 8 * 132; i += NTHREADS) { const int h = i / 132, d = i - h * 132;
        bt[i] = (d < 128) ? (rel_bias[t5_bucket(d) * 8 + h] - rel_bias[31 * 8 + h]) * LOG2E : 0.f; }
    __syncthreads();
    constexpr int W = 1 << 20, NITEM = 256;
    int L = F.vcu; if (L >= NITEM) return;
    int pass = 0;
    att::BlockRef<bf16, bf16> cur = attn_ref(L >> 3, L & 7, Q, K, V, mask, mixin);
    att::Seam<bf16> S;
    att::causal_swa_prime<bf16, bf16>(cur, W, lds, S, F.tid);
    for (;;) {
        const bool more_pass = pass == 0, more_item = L + F.G < NITEM, last = !more_pass && !more_item;
        int passn = pass + 1, Ln = L;
        if (!more_pass) { passn = 0; Ln = more_item ? L + F.G : L; }
        const att::BlockRef<bf16, bf16> nxt = last ? cur : attn_ref(Ln >> 3, passn ? 15 - (Ln & 7) : (Ln & 7), Q, K, V, mask, mixin);
        att::causal_swa_block<bf16, bf16>(cur, nxt, SEQ, W, lds, S, F.tid);
        if (last) break;
        cur = nxt; pass = passn; L = Ln;
    }
}

typedef __bf16 bf16x2_t __attribute__((ext_vector_type(2)));
__device__ __forceinline__ unsigned cvtpk_relu(float lo, float hi) { const int li = __float_as_int(lo), hi_i = __float_as_int(hi);
    const f32x2 v = {__int_as_float(li > 0 ? li : 0), __int_as_float(hi_i > 0 ? hi_i : 0)}; const bf16x2_t b = __builtin_convertvector(v, bf16x2_t); return __builtin_bit_cast(unsigned, b); }
__device__ __forceinline__ int half_sum_i(int v, int hi) {
    v += __builtin_amdgcn_update_dpp(0, v, 0xB1, 0xf, 0xf, true);
    v += __builtin_amdgcn_update_dpp(0, v, 0x4E, 0xf, 0xf, true);
    v += __builtin_amdgcn_update_dpp(0, v, 0x141, 0xf, 0xf, true);
    v += __builtin_amdgcn_update_dpp(0, v, 0x140, 0xf, 0xf, true);
    v += __builtin_amdgcn_update_dpp(0, v, 0x142, 0xa, 0xf, false);
    const int t0 = __builtin_amdgcn_readlane(v, 31), t1 = __builtin_amdgcn_readlane(v, 63);
    return hi ? t1 : t0;
}
__device__ __forceinline__ unsigned half_max_u(unsigned v, int hi) {
    unsigned t;
    t = (unsigned)__builtin_amdgcn_update_dpp(0, (int)v, 0xB1, 0xf, 0xf, true); v = t > v ? t : v;
    t = (unsigned)__builtin_amdgcn_update_dpp(0, (int)v, 0x4E, 0xf, 0xf, true); v = t > v ? t : v;
    t = (unsigned)__builtin_amdgcn_update_dpp(0, (int)v, 0x141, 0xf, 0xf, true); v = t > v ? t : v;
    t = (unsigned)__builtin_amdgcn_update_dpp(0, (int)v, 0x140, 0xf, 0xf, true); v = t > v ? t : v;
    t = (unsigned)__builtin_amdgcn_update_dpp(0, (int)v, 0x142, 0xa, 0xf, false); v = t > v ? t : v;
    const unsigned t0 = (unsigned)__builtin_amdgcn_readlane((int)v, 31), t1 = (unsigned)__builtin_amdgcn_readlane((int)v, 63);
    return hi ? t1 : t0;
}
constexpr int LN1_L_STATS = 132096;
constexpr int IDX_L_LIST = 148480;
constexpr int IDX_L_W2 = 132096;
__device__ __forceinline__ void indexer_unit(const Frame& F, int b, int u, const bf16* qi, const bf16* kiwi, unsigned* mask, bool pre  , bool has_next, int nb, int nu) {
    const int lane = F.lane, c = lane & 31, hi = lane >> 5, w = F.wave;
    const int b0 = b * SEQ, t0 = u * 16, tq = t0 + 2 * w + hi;
    const int nchunk = (t0 + 16 + 255) >> 8;
    LAS unsigned char* ring = F.lds;
    bf16x8 af[4];
    { const bf16* ap = qi + (size_t)(b0 + t0 + 2 * w + ((c >> 2) & 1)) * 1024 + ((c & 3) + 4 * (c >> 3)) * 64 + 8 * hi;
#pragma unroll
      for (int ks = 0; ks < 4; ++ks) af[ks] = *(const bf16x8*)(ap + 16 * ks); }
    f32x2 wv2[8];
    { const bf16* wp = kiwi + (size_t)(b0 + t0 + 2 * w + hi) * 256 + 64;
      const u32x4 wa = *(const u32x4*)wp, wb = *(const u32x4*)(wp + 8);
      wv2[0] = (f32x2){bflo(wa.x), bfhi(wa.x)}; wv2[1] = (f32x2){bflo(wa.y), bfhi(wa.y)}; wv2[2] = (f32x2){bflo(wa.z), bfhi(wa.z)}; wv2[3] = (f32x2){bflo(wa.w), bfhi(wa.w)};
      wv2[4] = (f32x2){bflo(wb.x), bfhi(wb.x)}; wv2[5] = (f32x2){bflo(wb.y), bfhi(wb.y)}; wv2[6] = (f32x2){bflo(wb.z), bfhi(wb.z)}; wv2[7] = (f32x2){bflo(wb.w), bfhi(wb.w)}; }
    const char* kbase = (const char*)(kiwi + (size_t)b0 * 256);
#define IDX_ISSUE2(kb_, nch_, ck) do { const int ckc_ = (ck) < (nch_) ? (ck) : (nch_) - 1; const char* g_ = (kb_) + (size_t)ckc_ * (256 * 512); \
        _Pragma("unroll") for (int i_ = 0; i_ < 4; ++i_) { const int p_ = (4 * w + i_) * 64 + lane, row_ = p_ >> 3; const unsigned so_ = (unsigned)(row_ * 512 + (((p_ & 7) ^ ((row_ >> 1) & 7)) << 4)); __builtin_amdgcn_global_load_lds((const unsigned*)(g_ + so_), (LAS unsigned*)(ring + ((ck) & 3) * 32768 + (4 * w + i_) * 1024), 16, 0, 0); } } while (0)
#define IDX_ISSUE(ck) IDX_ISSUE2(kbase, nchunk, ck)
    const unsigned bbase = (unsigned)(c * 128 + ((hi ^ ((c >> 1) & 7)) << 4));
    unsigned sc[128];
    if (!pre) { IDX_ISSUE(0); IDX_ISSUE(1); IDX_ISSUE(2); }
#pragma unroll
    for (int ck = 0; ck < 16; ++ck) {
        if (ck < nchunk) {
            asm volatile("s_waitcnt vmcnt(8)" ::: "memory"); __builtin_amdgcn_s_barrier(); asm volatile("" ::: "memory");
            IDX_ISSUE(ck + 3);
            unsigned cbv[4];
#pragma unroll
            for (int ks = 0; ks < 4; ++ks) { cbv[ks] = (bbase ^ (unsigned)(ks << 5)) + (unsigned)((ck & 3) * 32768); asm volatile("" : "+v"(cbv[ks])); }
            bf16x8 bq[4]; unsigned la[4]; f32x16 ac[2];
#define IDX_BREAD(t_) do { _Pragma("unroll") for (int ks = 0; ks < 4; ++ks) asm volatile("ds_read_b128 %0, %1 offset:%2" : "=v"(bq[ks]) : "v"(la[ks]), "n"((t_) * 4096)); } while (0)
#define IDX_BWAIT() asm volatile("s_waitcnt lgkmcnt(0)" : "+v"(bq[0]), "+v"(bq[1]), "+v"(bq[2]), "+v"(bq[3]))
#define IDX_MM(t_) do { f32x16 a_ = (f32x16){0.f, 0.f, 0.f, 0.f, 0.f, 0.f, 0.f, 0.f, 0.f, 0.f, 0.f, 0.f, 0.f, 0.f, 0.f, 0.f}; \
        _Pragma("unroll") for (int ks = 0; ks < 4; ++ks) a_ = __builtin_amdgcn_mfma_f32_32x32x16_bf16(af[ks], bq[ks], a_, 0, 0, 0); ac[(t_) & 1] = a_; } while (0)
#pragma unroll
            for (int ks = 0; ks < 4; ++ks) la[ks] = (unsigned)(size_t)(ring + cbv[ks]);
            IDX_BREAD(0); IDX_BWAIT(); IDX_MM(0);
            __builtin_amdgcn_sched_barrier(0);
            IDX_BREAD(1);
            __builtin_amdgcn_sched_barrier(0);
#pragma unroll
            for (int tt = 0; tt < 8; ++tt) {
                if (tt < 7) { IDX_BWAIT(); IDX_MM(tt + 1); }
                __builtin_amdgcn_sched_barrier(0);
                if (tt < 6) { IDX_BREAD(tt + 2); __builtin_amdgcn_sched_barrier(0); }
                const f32x16 acc = ac[tt & 1];
                f32x2 sm0 = (f32x2){0.f, 0.f}, sm1 = (f32x2){0.f, 0.f};
#pragma unroll
                for (int r = 0; r < 8; ++r) { const int a0 = __float_as_int(acc[2 * r]), a1 = __float_as_int(acc[2 * r + 1]);
                    const f32x2 av = (f32x2){__int_as_float(a0 > 0 ? a0 : 0), __int_as_float(a1 > 0 ? a1 : 0)};
                    if (r & 1) sm1 = av * wv2[r] + sm1; else sm0 = av * wv2[r] + sm0; }
                const f32x2 sm = sm0 + sm1;
                const float y0 = sm.x + sm.y;
                if (ck * 256 + 255 <= t0) sc[ck * 8 + tt] = sortable(y0);
                else { const int key = ck * 256 + tt * 32 + c; sc[ck * 8 + tt] = (key <= tq) ? sortable(y0) : 0u; }
                __builtin_amdgcn_sched_barrier(0);
            }
#undef IDX_BREAD
#undef IDX_BWAIT
#undef IDX_MM
        } else {
#pragma unroll
            for (int tt = 0; tt < 8; ++tt) sc[ck * 8 + tt] = 0u;
        }
    }
    asm volatile("s_waitcnt vmcnt(0)" ::: "memory"); __builtin_amdgcn_s_barrier(); asm volatile("" ::: "memory");
    if (has_next) {
        const char* kbn_ = (const char*)(kiwi + (size_t)(nb * SEQ) * 256); const int nchn_ = (nu * 16 + 16 + 255) >> 8;
        IDX_ISSUE2(kbn_, nchn_, 0); IDX_ISSUE2(kbn_, nchn_, 1); IDX_ISSUE2(kbn_, nchn_, 2); }
#undef IDX_ISSUE
#undef IDX_ISSUE2
    constexpr int MCAP = 64;
    unsigned kmx = 0u, kmn = 0xFFFFFFFFu;
#pragma unroll
    for (int ck = 0; ck < 16; ++ck) if (ck < nchunk) {
#pragma unroll
        for (int tt = 0; tt < 8; ++tt) kmx = sc[ck * 8 + tt] > kmx ? sc[ck * 8 + tt] : kmx; }
#pragma unroll
    for (int tt = 0; tt < 8; ++tt) kmn = sc[tt] < kmn ? sc[tt] : kmn;
    kmx = half_max_u(kmx, hi); kmn = ~half_max_u(~kmn, hi);
    const bool allsel = (tq + 1 <= TOPK);
    unsigned lo = allsel ? 0u : kmn, hk = allsel ? 0u : kmx + 1u;
    int clo = allsel ? 0 : tq + 1, chi = 0, side = -1;
    float glo = (float)clo - 255.5f, ghi = -255.5f;
    bool act = (clo - chi > MCAP) && (hk - lo > 1u);
#pragma unroll 1
    for (int it = 0; it < 160; ++it) {
        if (!__any(act)) break;
        float f = glo * __builtin_amdgcn_rcpf(glo - ghi);
        if (it >= 12 && (it & 1)) f = 0.5f;
        const float vlo = unsortable(lo), vhi = unsortable(hk);
        unsigned cand = sortable(vlo + (vhi - vlo) * f);
        if (it >= 48) cand = lo + ((hk - lo) >> 1);
        cand = cand <= lo ? lo + 1u : cand; cand = cand >= hk ? hk - 1u : cand;
        int cnt = 0;
#pragma unroll
        for (int ck = 0; ck < 16; ++ck) if (ck < nchunk) {
#pragma unroll
            for (int tt = 0; tt < 8; ++tt) cnt += (sc[ck * 8 + tt] >= cand) ? 1 : 0; }
        const int tot = half_sum_i(cnt, hi);
        if (act) {
            if (tot >= TOPK) { lo = cand; clo = tot; glo = (float)tot - 255.5f; if (side == 0) ghi *= 0.5f; side = 0; }
            else             { hk = cand; chi = tot; ghi = (float)tot - 255.5f; if (side == 1) glo *= 0.5f; side = 1; }
            act = (clo - chi > MCAP) && (hk - lo > 1u);
        }
    }
    const unsigned lt = (1u << c) - 1u;
    const bool uselist = !allsel && (hk - lo > 1u);
    const unsigned wdl = uselist ? hk - lo : 0u;
    LAS unsigned* lst = (LAS unsigned*)(F.lds + IDX_L_LIST + (w * 2 + hi) * 256);
    int pos = 0;
#pragma unroll
    for (int ck = 0; ck < 16; ++ck) if (ck < nchunk) {
#pragma unroll
        for (int tt = 0; tt < 8; ++tt) { const unsigned k = sc[ck * 8 + tt];
            const bool inb = (k - lo) < wdl;
            const unsigned long long bm = __ballot(inb);
            if (bm != 0ull) { const unsigned mh = hi ? (unsigned)(bm >> 32) : (unsigned)bm;
                if (inb) lst[pos + __popc(mh & lt)] = k;
                pos += __popc(mh); } } }
    asm volatile("s_waitcnt lgkmcnt(0)" ::: "memory");
    const int mm = max(__builtin_amdgcn_readlane(pos, 0), __builtin_amdgcn_readlane(pos, 32));
    const unsigned e0 = (c < pos) ? lst[c] : 0u, e1 = (c + 32 < pos) ? lst[c + 32] : 0u;
    int r0 = 0, r1 = 0;
#pragma unroll 1
    for (int j = 0; j < mm; ++j) { unsigned x = lst[j]; x = (j < pos) ? x : 0u; r0 += (x >= e0) ? 1 : 0; r1 += (x >= e1) ? 1 : 0; }
    const int needp = TOPK - chi;
    const unsigned q0 = (r0 >= needp) ? e0 : 0u, q1 = (r1 >= needp) ? e1 : 0u;
    const unsigned taul = half_max_u(q0 > q1 ? q0 : q1, hi);
    const unsigned tau = uselist ? taul : lo;
    const int cgl = half_sum_i(((e0 > tau) ? 1 : 0) + ((e1 > tau) ? 1 : 0), hi);
    const int need = TOPK - (chi + (uselist ? cgl : 0));
    unsigned* mrow = mask + (size_t)(b0 + tq) * 128;
    const int neq = half_sum_i(((e0 == tau) ? 1 : 0) + ((e1 == tau) ? 1 : 0), hi);
    const bool simple = allsel || (uselist && neq == need);
    unsigned wv = 0u;
    if (__all(simple)) {
        const unsigned tl = tau > 1u ? tau : 1u;
#pragma unroll
        for (int T = 0; T < 128; ++T) {
            unsigned word = 0u;
            if ((T >> 3) < nchunk) { const unsigned long long bs = __ballot(sc[T] >= tl); word = hi ? (unsigned)(bs >> 32) : (unsigned)bs; }
            if (c == (T & 31)) wv = word;
            if ((T & 31) == 31) mrow[(T >> 5) * 32 + c] = wv;
        }
        return;
    }
    int run = 0;
#pragma unroll
    for (int T = 0; T < 128; ++T) {
        unsigned word = 0u;
        if ((T >> 3) < nchunk) {
            const unsigned k = sc[T];
            const bool eq = (k == tau) && (k != 0u);
            const unsigned long long bm = __ballot(eq);
            const unsigned mh = hi ? (unsigned)(bm >> 32) : (unsigned)bm;
            const bool sel = ((k > tau) && (k != 0u)) || (eq && (run + __popc(mh & lt) < need));
            run += __popc(mh);
            const unsigned long long bs = __ballot(sel);
            word = hi ? (unsigned)(bs >> 32) : (unsigned)bs;
        }
        if (c == (T & 31)) wv = word;
        if ((T & 31) == 31) mrow[(T >> 5) * 32 + c] = wv;
    }
}
__device__ __forceinline__ void phase_indexer_fast(const Frame& F, const bf16* qi, const bf16* kiwi, unsigned* mask) {
    for (int base = F.vcu; base < 256; base += F.G) {
#pragma unroll 1
        for (int i = 0; i < 4; ++i) indexer_unit(F, i, (i & 1) ? 255 - base : base, qi, kiwi, mask, i > 0, i < 3, i + 1, ((i + 1) & 1) ? 255 - base : base);
    }
}

struct Args { const float* in[14]; float* out; unsigned char* ws; };

__global__ void __launch_bounds__(NTHREADS, 2) mega_fwd(Args args) {
    extern __shared__ __attribute__((aligned(16))) unsigned char lds[];
#define FRAME_INIT() Frame F; { int l_; asm volatile("v_mbcnt_lo_u32_b32 %0, -1, 0\n\tv_mbcnt_hi_u32_b32 %0, -1, %0" : "=v"(l_)); const int t_ = wave0 * 64 + l_; F.lds = (LAS unsigned char*)lds; F.ldsg = lds; F.tid = t_; F.lane = l_; F.wave = wave0; \
        F.G = gridDim.x; const int bx_ = blockIdx.x; F.vcu = (F.G % 8 == 0) ? (bx_ % 8) * (F.G / 8) + bx_ / 8 : bx_; }
    LAS unsigned char* ldsl = (LAS unsigned char*)lds;
    const int wave0 = __builtin_amdgcn_readfirstlane(threadIdx.x >> 6);
    volatile LAS unsigned* MISC = (volatile LAS unsigned*)(ldsl + MISC_OFF);
    unsigned char* ws = args.ws;
    gu32* ctl = (gu32*)(ws + WS_CTL);
    const float* x = args.in[0]; const float* w_in = args.in[1]; const float* pool_w = args.in[2]; const float* pool_scale = args.in[3];
    const float* rel_bias = args.in[4]; const float* w_out = args.in[5]; const float* ln1_g = args.in[6]; const float* ln1_b = args.in[7];
    const float* peer_wq = args.in[8]; const float* peer_sub = args.in[9]; const float* peer_u = args.in[10]; const float* peer_v = args.in[11];
    const float* ln2_g = args.in[12]; const float* ln2_b = args.in[13];
    float* out = args.out;
    bf16* PoolWT = (bf16*)(ws + WS_POOLWT); bf16* WoutT = (bf16*)(ws + WS_WOUTT); bf16* WqT = (bf16*)(ws + WS_WQT); bf16* WinT = (bf16*)(ws + WS_WINT);
    bf16* KIWI = (bf16*)(ws + WS_KIWI); unsigned* MASK = (unsigned*)(ws + WS_MASK); bf16* POOLED = (bf16*)(ws + WS_POOLED);
    bf16* XB = (bf16*)(ws + WS_XB); bf16* MIXIN = (bf16*)(ws + WS_MIXIN);
    bf16* PV = (bf16*)(ws + WS_PV); bf16* Qb = (bf16*)(ws + WS_Q); bf16* Kb = (bf16*)(ws + WS_K); bf16* Vb = (bf16*)(ws + WS_V); bf16* QI = (bf16*)(ws + WS_QI);
    float* STATS = (float*)(ws + WS_STATSP); float* CSUM = (float*)(ws + WS_CSUM); float* BVEC = (float*)(ws + WS_BVEC); float* CSP = (float*)(ws + WS_CSP); float* BVP = (float*)(ws + WS_BVP);
    bf16* HB = (bf16*)(ws + WS_HB); bf16* QP = (bf16*)(ws + WS_QP); unsigned char* U8 = ws + WS_U8; unsigned char* V8 = ws + WS_V8;
    int* EIDX = (int*)(ws + WS_EIDX); float* GATE = (float*)(ws + WS_GATE); float* ISU = (float*)(ws + WS_ISU); float* ISV = (float*)(ws + WS_ISV); bf16* SKB = (bf16*)(ws + WS_SKB);

    for (int u = threadIdx.x; u < (LDS_BYTES - LDSCTL_OFF) / 4; u += NTHREADS) ((LAS unsigned*)(ldsl + LDSCTL_OFF))[u] = 0u;
    __syncthreads();
    XcdBarrier bar = xcd_barrier_post((unsigned*)(ctl + CW_BAR), MISC + 8);

    { FRAME_INIT(); p0_first(F, x, w_in, XB, WinT); }
    xcd_barrier(bar);
    { FRAME_INIT(); const int ndef = F.G / 8, gG = F.G - ndef, c = (int)blockIdx.x;
      if (c >= gG) { p0_deferred(F, c - gG, ndef, pool_w, w_out, peer_wq, PoolWT, WoutT, WqT, ln1_g, ln1_b, CSP, BVP, peer_sub, SKB, peer_u, peer_v, U8, ISU, ISV); }
      else { pg8::Gemm g{XB, WinT, M_TOK, D_IN_PAD, 2048, 2048, 2048, 0, 20}; pg8::StaticOrder S; S.init(M_TOK, D_IN_PAD, gG, c);
        pg8::EpiProj E{PV, (size_t)M_TOK * 1024, KIWI};
        pg8::gemm_phase<pg8::EpiProj, pg8::StaticOrder, true, true>(F.lds + RING_OFF, g, S, E, F.tid); } }
    xcd_barrier(bar);
    { FRAME_INIT(); ln1_fold_reduce(F, CSP, BVP, CSUM, BVEC); }
    { FRAME_INIT(); if ((F.vcu & 1) == 0) phase_pool_prep(F, PV, POOLED); }
    { FRAME_INIT(); phase_indexer_fast(F, QI, KIWI, MASK); }
    { FRAME_INIT(); if ((F.vcu & 1) != 0) phase_pool_prep(F, PV, POOLED); }
    xcd_barrier(bar);
    { FRAME_INIT(); pg8::Gemm g{POOLED, PoolWT, M_TOK, 1024, 256, 1024, 256, 256, -1}; pg8::StaticOrder S; S.init(M_TOK, 1024, F.G, (int)blockIdx.x);
      pg8::EpiBf16S E{MIXIN, 2048, pool_scale};
      pg8::gemm_phase<pg8::EpiBf16S, pg8::StaticOrder, true, true>(F.lds + RING_OFF, g, S, E, F.tid); }
    __syncthreads();
    { FRAME_INIT(); phase_attn_fast(F, Qb, Kb, Vb, MASK, rel_bias, MIXIN); }
    xcd_barrier(bar);
    { FRAME_INIT(); pg8::Gemm g{MIXIN, WoutT, M_TOK, 2048, 2048, 2048, 2048, 0, -1}; pg8::StaticOrder S; S.init(M_TOK, 2048, F.G, (int)blockIdx.x);
      LAS float* lst = (LAS float*)(F.lds + LN1_L_STATS);
#pragma unroll
      for (int i = 0; i < 8; ++i) lst[F.tid + 512 * i] = 0.f;
      pg8::Unit u0, ui; const bool any = S.next(0, u0); bool same = true; int nun = any ? 1 : 0;
      for (int i = 1; S.next(i, ui); ++i) { same = same && (ui.pm == u0.pm); ++nun; }
      const bool fast = any && same && nun <= 2 && u0.pn < 4;
      __syncthreads();
      pg8::EpiResBf16St E{(bf16*)(ws + 392 * MiB), x, 2048, ALPHA, fast ? lst : (LAS float*)nullptr, STATS};
      pg8::gemm_phase<pg8::EpiResBf16St, pg8::StaticOrder, true, true>(F.lds + RING_OFF, g, S, E, F.tid); }
    __syncthreads();
    { FRAME_INIT(); pg8::StaticOrder S; S.init(M_TOK, 2048, F.G, (int)blockIdx.x);
      pg8::Unit u0, ui; const bool any = S.next(0, u0); bool same = true; int nun = any ? 1 : 0;
      for (int i = 1; S.next(i, ui); ++i) { same = same && (ui.pm == u0.pm); ++nun; }
      if (any && same && nun <= 2 && u0.pn < 4) { LAS const float* lp = (LAS const float*)(F.lds + LN1_L_STATS) + F.tid; float v = 0.f;
#pragma unroll
          for (int i = 0; i < 8; ++i) v += lp[512 * i];
          STATS[(size_t)u0.pm * 2048 + (u0.pn & 3) * 512 + F.tid] = v; } }
    xcd_barrier(bar);
    { FRAME_INIT(); pg8::Gemm g{(const bf16*)(ws + 392 * MiB), WqT, M_TOK, 2048, 2048, 2048, 2048, 0, -1}; pg8::StaticOrder S; S.init(M_TOK, 2048, F.G, (int)blockIdx.x);
      pg8::EpiLNFold E{QP, 2048, STATS, CSUM, BVEC};
      pg8::gemm_phase<pg8::EpiLNFold, pg8::StaticOrder, true, true>(F.lds + RING_OFF, g, S, E, F.tid); }
    xcd_barrier(bar);
    { FRAME_INIT(); phase_peer_fast(F, out, (const bf16*)(ws + 392 * MiB), STATS, QP, SKB, EIDX, GATE, U8, ISU, ISV, ln2_g, ln2_b, ln1_g, ln1_b); }
}

extern "C" void kernel_launch(void* const* d_in, const int* in_sizes, int n_in, void* d_out, int out_size, void* d_ws, size_t ws_size, hipStream_t stream) {
    static int grid = 0;
    if (grid == 0) {
        if (n_in != 14 || out_size != M_TOK * D_MODEL || ws_size < WS_END) { fprintf(stderr, "kernel_launch: unexpected shapes (n_in %d out %d ws %zu)\n", n_in, out_size, ws_size); grid = -1; return; }
        int dev = 0, cus = 0, per_cu = 0;
        if (hipGetDevice(&dev) != hipSuccess || hipDeviceGetAttribute(&cus, hipDeviceAttributeMultiprocessorCount, dev) != hipSuccess) { grid = -1; return; }
        if (hipFuncSetAttribute((const void*)mega_fwd, hipFuncAttributeMaxDynamicSharedMemorySize, LDS_BYTES) != hipSuccess) { fprintf(stderr, "kernel_launch: hipFuncSetAttribute failed\n"); grid = -1; return; }
        if (hipOccupancyMaxActiveBlocksPerMultiprocessor(&per_cu, (const void*)mega_fwd, NTHREADS, LDS_BYTES) != hipSuccess || per_cu < 1) fprintf(stderr, "kernel_launch: occupancy query says %d\n", per_cu);
        (void)hipGetLastError();
        grid = cus;
    }
    if (grid < 0) return;
    if (hipMemsetAsync((char*)d_ws + WS_CTL, 0, CTL_ZERO_BYTES, stream) != hipSuccess) { fprintf(stderr, "kernel_launch: memset failed\n"); return; }
    Args a{};
    for (int i = 0; i < 14; ++i) a.in[i] = (const float*)d_in[i];
    a.out = (float*)d_out; a.ws = (unsigned char*)d_ws;
    hipLaunchKernelGGL(mega_fwd, dim3(grid), dim3(NTHREADS), LDS_BYTES, stream, a);
}
```

```cpp
#include <hip/hip_runtime.h>
#include <cstdint>
#include <cstdio>

constexpr int D_MODEL = 2048, BATCH = 4, SEQ = 4096, M_TOK = BATCH * SEQ;
constexpr int D_POOL = 1024, D_ATTN = 1024, N_HEADS = 8, HEAD_DIM = 128;
constexpr int IDX_HEADS = 16, IDX_DIM = 64, TOPK = 256;
constexpr int D_IN = 5200, D_IN_PAD = 5376;
constexpr int PEER_HEADS = 8, PEER_KEYS = 128, PEER_HALF = 128, PEER_TOPK = 16, N_EXPERTS = 16384;
constexpr float ALPHA = 1.189207115002721f;
constexpr float LN_EPS = 1e-5f;
constexpr float LOG2E = 1.4426950408889634f;
constexpr float QSCALE = 0.08838834764831845f * LOG2E;

constexpr size_t MiB = 1ull << 20;
constexpr size_t WS_CTL = 0, CTL_ZERO_BYTES = 768 * 1024;
constexpr size_t WS_CSUM = 192 * 1024, WS_BVEC = 200 * 1024;
constexpr size_t WS_STATSP = 256 * 1024;
constexpr size_t WS_CSP = 464 * MiB, WS_BVP = 464 * MiB + 256 * 1024;
constexpr size_t WS_POOLWT = 1 * MiB, WS_WOUTT = 2 * MiB, WS_WQT = 10 * MiB, WS_WINT = 18 * MiB;
constexpr size_t WS_KIWI = 40 * MiB;
constexpr size_t WS_MASK = 48 * MiB;
constexpr size_t WS_POOLED = 56 * MiB;
constexpr size_t WS_XB = 392 * MiB;
constexpr size_t WS_MIXIN = 88 * MiB;
constexpr size_t WS_PV = 152 * MiB, WS_Q = 184 * MiB, WS_K = 216 * MiB, WS_V = 248 * MiB, WS_QI = 280 * MiB;
constexpr size_t WS_HB = 152 * MiB;
constexpr size_t WS_QP = 216 * MiB;
constexpr size_t WS_U8 = 312 * MiB, WS_V8 = 344 * MiB;
constexpr size_t WS_EIDX = 376 * MiB, WS_GATE = 384 * MiB;
constexpr size_t WS_ISU = 1 * MiB + 512 * 1024, WS_ISV = WS_ISU + 65536, WS_SKB = WS_ISV + 65536;
constexpr size_t WS_END = 465 * MiB;
constexpr int CW_BAR = 4096;

namespace pg8 {
#define PG8_LAS __attribute__((address_space(3)))
typedef unsigned short bf16_t;
typedef short bf16x8 __attribute__((ext_vector_type(8)));
typedef float f32x4 __attribute__((ext_vector_type(4)));
typedef unsigned u32x4 __attribute__((ext_vector_type(4)));
constexpr int BM = 256, BK = 64, HALF = 128, HTB = HALF * BK * 2  , STAGE_BYTES = 8 * HTB, NXCD = 8, WGM = 8;

__host__ __device__ __forceinline__ int lds_byte(int r, int c) { const int st = (r >> 4) * 2 + (c >> 5), rr = r & 15, cc = c & 31, ob = rr * 64 + cc * 2; return st * 1024 + (ob ^ (((ob >> 9) & 1) << 5)); }
__host__ __device__ __forceinline__ void stage_rc(int b, int& R, int& C) { const int st = b / 1024, sb = b % 1024, swz = sb ^ (((sb >> 9) & 1) << 5); R = (st >> 1) * 16 + swz / 64; C = (st & 1) * 32 + (swz % 64) / 2; }
__host__ __device__ __forceinline__ int perm32(int rho) { const int n = rho >> 4, i = rho & 15; return 8 * (i >> 2) + 4 * n + (i & 3); }

struct Unit { int pm, pn, ord; };
struct Gemm { const bf16_t* A; const bf16_t* Bt; int M, N, K; int lda, ldb; int a_pn_off; int narrow_pn; };

struct StaticOrder {
    int nM, nN, nwg, G, c, ib, ie;
    __host__ __device__ __forceinline__ void init(int M, int N, int G_, int c_) { nM = M / BM; nN = N / BM; nwg = nM * nN; G = G_; c = c_; ib = 0; ie = 1 << 30; }
    __host__ __device__ __forceinline__ bool next(int i, Unit& u) const {
        if (ib + i >= ie) return false;
        const long L = (long)(ib + i) * G + c; if (L >= nwg) return false;
        int wgid = (int)L; { const int q = nwg / NXCD, r = nwg % NXCD, xcd = wgid % NXCD, off = wgid / NXCD; wgid = (xcd < r ? xcd * (q + 1) : r * (q + 1) + (xcd - r) * q) + off; }
        const int nig = WGM * nN, gid = wgid / nig, fm = gid * WGM, gsz = (nM - fm) < WGM ? (nM - fm) : WGM;
        u.pm = fm + ((wgid % nig) % gsz); u.pn = (wgid % nig) / gsz; u.ord = ib + i; return true;
    }
    __device__ __forceinline__ void a_ready(const Unit&) const {}
    __device__ __forceinline__ void done(const Unit&) const {}
};

__device__ __forceinline__ unsigned cvt_pk_bf16(float lo, float hi) { unsigned r; asm volatile("v_cvt_pk_bf16_f32 %0, %1, %2" : "=v"(r) : "v"(lo), "v"(hi)); return r; }

struct EpiProj {
    static constexpr bool PERM = true, AFTER_DRAIN = false;
    bf16_t* O; size_t split_stride; bf16_t* kiwi;
    __device__ __forceinline__ void operator()(const f32x4 (&acc)[2][2][4][2], const Unit& u, int wr, int wc, int fr, int fq) const {
        const int row0 = u.pm * BM + wr * 64 + fr;
        bf16_t* base; int colt, ldc; float sc = 1.f;
        if (u.pn < 20) { const int t = u.pn >> 2; base = O + (size_t)t * split_stride; colt = (u.pn & 3) * BM; ldc = 1024; if (t == 1) sc = QSCALE; }
        else { base = kiwi; colt = 0; ldc = 256; }
        const int col0 = colt + wc * 32 + 8 * fq;
#pragma unroll
        for (int ai = 0; ai < 2; ++ai)
#pragma unroll
            for (int m = 0; m < 4; ++m) { bf16_t* rowp = base + (size_t)(row0 + ai * HALF + m * 16) * ldc + col0;
#pragma unroll
                for (int bj = 0; bj < 2; ++bj) { const f32x4 v0 = acc[ai][bj][m][0] * sc, v1 = acc[ai][bj][m][1] * sc;
                    u32x4 w; w.x = cvt_pk_bf16(v0[0], v0[1]); w.y = cvt_pk_bf16(v0[2], v0[3]); w.z = cvt_pk_bf16(v1[0], v1[1]); w.w = cvt_pk_bf16(v1[2], v1[3]);
                    *(u32x4*)(rowp + bj * HALF) = w; } }
    }
};
struct EpiBf16S {
    static constexpr bool PERM = true, AFTER_DRAIN = false;
    bf16_t* O; int ldc; const float* colscale;
    __device__ __forceinline__ void operator()(const f32x4 (&acc)[2][2][4][2], const Unit& u, int wr, int wc, int fr, int fq) const {
        const int row0 = u.pm * BM + wr * 64 + fr, col0 = u.pn * BM + wc * 32 + 8 * fq;
        f32x4 sv[2][2];
#pragma unroll
        for (int bj = 0; bj < 2; ++bj)
#pragma unroll
            for (int n = 0; n < 2; ++n) sv[bj][n] = colscale ? *(const f32x4*)(colscale + col0 + bj * HALF + 4 * n) : (f32x4){1.f, 1.f, 1.f, 1.f};
#pragma unroll
        for (int ai = 0; ai < 2; ++ai)
#pragma unroll
            for (int m = 0; m < 4; ++m) { bf16_t* rowp = O + (size_t)(row0 + ai * HALF + m * 16) * ldc + col0;
#pragma unroll
                for (int bj = 0; bj < 2; ++bj) { const f32x4 v0 = acc[ai][bj][m][0] * sv[bj][0], v1 = acc[ai][bj][m][1] * sv[bj][1];
                    u32x4 w; w.x = cvt_pk_bf16(v0[0], v0[1]); w.y = cvt_pk_bf16(v0[2], v0[3]); w.z = cvt_pk_bf16(v1[0], v1[1]); w.w = cvt_pk_bf16(v1[2], v1[3]);
                    *(u32x4*)(rowp + bj * HALF) = w; } }
    }
};
struct EpiResF32 {
    static constexpr bool PERM = false, AFTER_DRAIN = false;
    float* C; const float* R; int ldc; float alpha;
    __device__ __forceinline__ void operator()(const f32x4 (&acc)[2][2][4][2], const Unit& u, int wr, int wc, int fr, int fq) const {
        const int row0 = u.pm * BM + wr * 64 + fr, col0 = u.pn * BM + wc * 32 + 4 * fq;
#pragma unroll
        for (int ai = 0; ai < 2; ++ai)
#pragma unroll
            for (int m = 0; m < 4; ++m) { const size_t off = (size_t)(row0 + ai * HALF + m * 16) * ldc + col0;
#pragma unroll
                for (int bj = 0; bj < 2; ++bj)
#pragma unroll
                    for (int n = 0; n < 2; ++n) { const f32x4 r = *(const f32x4*)(R + off + bj * HALF + n * 16); *(f32x4*)(C + off + bj * HALF + n * 16) = r * alpha + acc[ai][bj][m][n]; } }
    }
};
struct EpiResBf16 {
    static constexpr bool PERM = true, AFTER_DRAIN = false;
    bf16_t* O; const float* R; int ldc; float alpha;
    __device__ __forceinline__ void operator()(const f32x4 (&acc)[2][2][4][2], const Unit& u, int wr, int wc, int fr, int fq) const {
        const int row0 = u.pm * BM + wr * 64 + fr, col0 = u.pn * BM + wc * 32 + 8 * fq;
#pragma unroll
        for (int ai = 0; ai < 2; ++ai)
#pragma unroll
            for (int m = 0; m < 4; ++m) { const size_t off = (size_t)(row0 + ai * HALF + m * 16) * ldc + col0;
#pragma unroll
                for (int bj = 0; bj < 2; ++bj) { const u32x4 rr = *(const u32x4*)(R + off + bj * HALF);
                    const f32x4 r0 = {__uint_as_float(rr.x << 16), __uint_as_float(rr.x & 0xffff0000u), __uint_as_float(rr.y << 16), __uint_as_float(rr.y & 0xffff0000u)};
                    const f32x4 r1 = {__uint_as_float(rr.z << 16), __uint_as_float(rr.z & 0xffff0000u), __uint_as_float(rr.w << 16), __uint_as_float(rr.w & 0xffff0000u)};
                    const f32x4 v0 = r0 * alpha + acc[ai][bj][m][0], v1 = r1 * alpha + acc[ai][bj][m][1];
                    u32x4 w; w.x = cvt_pk_bf16(v0[0], v0[1]); w.y = cvt_pk_bf16(v0[2], v0[3]); w.z = cvt_pk_bf16(v1[0], v1[1]); w.w = cvt_pk_bf16(v1[2], v1[3]);
                    *(u32x4*)(O + off + bj * HALF) = w; } }
    }
};

__device__ __forceinline__ void ln1_row_stats(const float* sp, int r, float& mean, float& rstd) {
    const float* p = sp + (size_t)(r >> 8) * 2048 + 2 * (r & 255);
    const float s0 = ((p[0] + p[512]) + p[1024]) + p[1536], s1 = ((p[1] + p[513]) + p[1025]) + p[1537];
    mean = s0 * (1.f / 2048.f); rstd = 1.f / sqrtf(fmaxf(s1 * (1.f / 2048.f) - mean * mean, 0.f) + LN_EPS);
}
struct EpiLNFold {
    static constexpr bool PERM = true, AFTER_DRAIN = false;
    bf16_t* O; int ldc; const float* st; const float* csum; const float* bvec;
    __device__ __forceinline__ void operator()(const f32x4 (&acc)[2][2][4][2], const Unit& u, int wr, int wc, int fr, int fq) const {
        const int row0 = u.pm * BM + wr * 64 + fr, col0 = u.pn * BM + wc * 32 + 8 * fq;
#pragma unroll
        for (int ai = 0; ai < 2; ++ai)
#pragma unroll
            for (int m = 0; m < 4; ++m) { const int r = row0 + ai * HALF + m * 16; bf16_t* rowp = O + (size_t)r * ldc + col0;
                float mean, rstd; ln1_row_stats(st, r, mean, rstd); const float nm = -mean * rstd;
#pragma unroll
                for (int bj = 0; bj < 2; ++bj) { const float* cp = csum + col0 + bj * HALF; const float* bp = bvec + col0 + bj * HALF;
                    const f32x4 c0 = *(const f32x4*)cp, c1 = *(const f32x4*)(cp + 4), b0 = *(const f32x4*)bp, b1 = *(const f32x4*)(bp + 4);
                    const f32x4 v0 = acc[ai][bj][m][0] * rstd + (c0 * nm + b0), v1 = acc[ai][bj][m][1] * rstd + (c1 * nm + b1);
                    u32x4 w; w.x = cvt_pk_bf16(v0[0], v0[1]); w.y = cvt_pk_bf16(v0[2], v0[3]); w.z = cvt_pk_bf16(v1[0], v1[1]); w.w = cvt_pk_bf16(v1[2], v1[3]);
                    *(u32x4*)(rowp + bj * HALF) = w; } }
    }
};
typedef __bf16 bf2_t __attribute__((ext_vector_type(2)));
struct EpiResBf16St {
    static constexpr bool PERM = true, AFTER_DRAIN = false;
    bf16_t* O; const bf16_t* R; int ldc; float alpha; PG8_LAS float* lst; float* gst;
    __device__ __forceinline__ void operator()(const f32x4 (&acc)[2][2][4][2], const Unit& u, int wr, int wc, int fr, int fq) const {
        const int row0 = u.pm * BM + wr * 64 + fr, col0 = u.pn * BM + wc * 32 + 8 * fq;
#pragma unroll
        for (int ai = 0; ai < 2; ++ai)
#pragma unroll
            for (int m = 0; m < 4; ++m) { const size_t off = (size_t)(row0 + ai * HALF + m * 16) * ldc + col0; float sm = 0.f, sq = 0.f;
#pragma unroll
                for (int bj = 0; bj < 2; ++bj) { const u32x4 rr = *(const u32x4*)(R + off + bj * HALF);
                    const f32x4 r0 = {__uint_as_float(rr.x << 16), __uint_as_float(rr.x & 0xffff0000u), __uint_as_float(rr.y << 16), __uint_as_float(rr.y & 0xffff0000u)};
                    const f32x4 r1 = {__uint_as_float(rr.z << 16), __uint_as_float(rr.z & 0xffff0000u), __uint_as_float(rr.w << 16), __uint_as_float(rr.w & 0xffff0000u)};
                    const f32x4 v0 = r0 * alpha + acc[ai][bj][m][0], v1 = r1 * alpha + acc[ai][bj][m][1];
                    u32x4 w; w.x = cvt_pk_bf16(v0[0], v0[1]); w.y = cvt_pk_bf16(v0[2], v0[3]); w.z = cvt_pk_bf16(v1[0], v1[1]); w.w = cvt_pk_bf16(v1[2], v1[3]);
                    *(u32x4*)(O + off + bj * HALF) = w;
                    const unsigned one2 = 0x3F803F80u; const unsigned wx = w.x, wy = w.y, wz = w.z, ww = w.w;
#define PG8_ST(q_) do { const bf2_t b_ = __builtin_bit_cast(bf2_t, q_); sm = __builtin_amdgcn_fdot2_f32_bf16(b_, __builtin_bit_cast(bf2_t, one2), sm, false); sq = __builtin_amdgcn_fdot2_f32_bf16(b_, b_, sq, false); } while (0)
                    PG8_ST(wx); PG8_ST(wy); PG8_ST(wz); PG8_ST(ww);
#undef PG8_ST
                    }
                { auto r = __builtin_amdgcn_permlane32_swap(__float_as_uint(sm), __float_as_uint(sm), false, false); sm = __uint_as_float(r[0]) + __uint_as_float(r[1]); }
                { auto r = __builtin_amdgcn_permlane16_swap(__float_as_uint(sm), __float_as_uint(sm), false, false); sm = __uint_as_float(r[0]) + __uint_as_float(r[1]); }
                { auto r = __builtin_amdgcn_permlane32_swap(__float_as_uint(sq), __float_as_uint(sq), false, false); sq = __uint_as_float(r[0]) + __uint_as_float(r[1]); }
                { auto r = __builtin_amdgcn_permlane16_swap(__float_as_uint(sq), __float_as_uint(sq), false, false); sq = __uint_as_float(r[0]) + __uint_as_float(r[1]); }
                if (fq == 0) { const int rl = ai * HALF + wr * 64 + m * 16 + fr;
                    if (lst) { PG8_LAS float* lp = lst + ((u.ord & 1) * 4 + wc) * 512 + 2 * rl; lp[0] = sm; lp[1] = sq; }
                    else { float* gp = gst + (size_t)u.pm * 2048 + 2 * rl; __hip_atomic_fetch_add(gp, sm, __ATOMIC_RELAXED, __HIP_MEMORY_SCOPE_AGENT); __hip_atomic_fetch_add(gp + 1, sq, __ATOMIC_RELAXED, __HIP_MEMORY_SCOPE_AGENT); } } }
    }
};

template <class Epi, class Sched, bool ALIGN_EPI = false, bool SP2 = false>
__device__ __forceinline__ void gemm_phase(PG8_LAS unsigned char* lds, const Gemm g, const Sched& S, const Epi& E, const int tid_in  ) {
    const int tid = tid_in, wid = __builtin_amdgcn_readfirstlane(tid >> 6), lane = tid & 63, wr = wid >> 2, wc = wid & 3, fr = lane & 15, fq = lane >> 4;
    const int K = g.K, nt = K / BK;
    unsigned voffA[2], voffB[2];
#pragma unroll
    for (int i = 0; i < 2; ++i) { int R, C; stage_rc(tid * 16 + i * 8192, R, C); const int Rb = Epi::PERM ? ((R & ~31) + perm32(R & 31)) : R;
        voffA[i] = (unsigned)(R * g.lda + C) * 2u; voffB[i] = (unsigned)(Rb * g.ldb + C) * 2u; }
    const size_t kstep = (size_t)(BK * 2);
    const size_t hsA = (size_t)HALF * g.lda * 2, hsB = (size_t)HALF * g.ldb * 2;
    const size_t tsA = 2 * hsA, tsB = 2 * hsB, pnA = (size_t)g.a_pn_off * 2;
    const unsigned ldsw = (unsigned)wid * 1024u;
    const int aoff = lds_byte(wr * 64 + fr, fq * 8), boff = lds_byte(wc * 32 + fr, fq * 8);
#define PG8_SA(b, h) (((b) * 2 + (h)) * HTB)
#define PG8_SB(b, h) ((4 + (b) * 2 + (h)) * HTB)
#define PG8_STAGE(bufoff, gbase, voff) do { _Pragma("unroll") for (int _i = 0; _i < 2; ++_i) \
        __builtin_amdgcn_global_load_lds((const unsigned*)((const char*)(gbase) + (voff)[_i]), (PG8_LAS unsigned*)(lds + (bufoff) + ldsw + _i * 8192), 16, 0, 0); } while (0)
#define PG8_LDA(dst, b, h) do { _Pragma("unroll") for (int m = 0; m < 4; ++m) _Pragma("unroll") for (int k = 0; k < 2; ++k) dst[m][k] = *(const PG8_LAS bf16x8*)(lds + PG8_SA(b, h) + aoff + m * 2048 + k * 1024); } while (0)
#define PG8_LDB(dst, b, h) do { _Pragma("unroll") for (int n = 0; n < 2; ++n) _Pragma("unroll") for (int k = 0; k < 2; ++k) dst[n][k] = *(const PG8_LAS bf16x8*)(lds + PG8_SB(b, h) + boff + n * 2048 + k * 1024); } while (0)
#define PG8_MMA(ai, bj, At, Bt) do { __builtin_amdgcn_s_setprio(1); _Pragma("unroll") for (int m = 0; m < 4; ++m) _Pragma("unroll") for (int n = 0; n < 2; ++n) _Pragma("unroll") for (int k = 0; k < 2; ++k) \
        acc[ai][bj][m][n] = __builtin_amdgcn_mfma_f32_16x16x32_bf16(Bt[n][k], At[m][k], acc[ai][bj][m][n], 0, 0, 0); __builtin_amdgcn_s_setprio(0); } while (0)
#define PG8_WAIT_V(n) asm volatile("s_waitcnt vmcnt(" #n ")" ::: "memory")
#define PG8_WAIT_L(n) asm volatile("s_waitcnt lgkmcnt(" #n ")" ::: "memory")
#define PG8_BAR __builtin_amdgcn_s_barrier()
#define PG8_SCHED __builtin_amdgcn_sched_barrier(0)
    Unit cur, nxt; int ui = 0;
    if (!S.next(0, cur)) return;
    f32x4 acc[2][2][4][2];
#pragma unroll
    for (int a = 0; a < 2; ++a)
#pragma unroll
        for (int b = 0; b < 2; ++b)
#pragma unroll
            for (int m = 0; m < 4; ++m)
#pragma unroll
                for (int n = 0; n < 2; ++n) acc[a][b][m][n] = (f32x4){0.f, 0.f, 0.f, 0.f};
    bf16x8 At[4][2], B0[2][2], B1[2][2];
    const char* cA = (const char*)g.A + (size_t)cur.pm * tsA + (size_t)cur.pn * pnA; const char* cB = (const char*)g.Bt + (size_t)cur.pn * tsB;
    S.a_ready(cur);
    if constexpr (SP2) {
        PG8_STAGE(PG8_SB(0, 0), cB, voffB); PG8_STAGE(PG8_SB(0, 1), cB + hsB, voffB); PG8_STAGE(PG8_SA(0, 0), cA, voffA); PG8_STAGE(PG8_SA(0, 1), cA + hsA, voffA);
        if (wr == 1) PG8_BAR;
        PG8_WAIT_V(2); PG8_BAR;
        PG8_STAGE(PG8_SB(1, 0), cB + kstep, voffB); PG8_STAGE(PG8_SA(1, 0), cA + kstep, voffA); PG8_STAGE(PG8_SB(1, 1), cB + hsB + kstep, voffB);
        PG8_WAIT_V(6); PG8_BAR;
    } else {
        PG8_STAGE(PG8_SB(0, 0), cB, voffB); PG8_STAGE(PG8_SA(0, 0), cA, voffA); PG8_STAGE(PG8_SB(0, 1), cB + hsB, voffB); PG8_STAGE(PG8_SA(0, 1), cA + hsA, voffA);
        if (wr == 1) PG8_BAR;
        PG8_WAIT_V(4); PG8_BAR;
        PG8_STAGE(PG8_SB(1, 0), cB + kstep, voffB); PG8_STAGE(PG8_SA(1, 0), cA + kstep, voffA); PG8_STAGE(PG8_SB(1, 1), cB + hsB + kstep, voffB);
        PG8_WAIT_V(6); PG8_BAR;
    }
    for (;;) {
        const bool has_next = S.next(ui + 1, nxt);
        const bool b1on = (cur.pn != g.narrow_pn);
        const char* nA = has_next ? (const char*)g.A + (size_t)nxt.pm * tsA + (size_t)nxt.pn * pnA : cA; const char* nB = has_next ? (const char*)g.Bt + (size_t)nxt.pn * tsB : cB;
        for (int t = 0; t < nt; t += 2) {
            const bool last = (t == nt - 2);
            const char* a1 = cA + (size_t)(t + 1) * kstep;
            const char* a2 = last ? nA : cA + (size_t)(t + 2) * kstep; const char* b2 = last ? nB : cB + (size_t)(t + 2) * kstep;
            const char* a3 = a2 + kstep; const char* b3 = b2 + kstep;
            if (last && has_next) S.a_ready(nxt);
            if constexpr (SP2) {
            PG8_LDB(B0, 0, 0); PG8_LDB(B1, 0, 1); PG8_SCHED; PG8_LDA(At, 0, 0); PG8_STAGE(PG8_SA(1, 1), a1 + hsA, voffA);
            PG8_WAIT_V(8); PG8_WAIT_L(0); PG8_BAR; PG8_MMA(0, 0, At, B0); if (b1on) PG8_MMA(0, 1, At, B1); PG8_BAR; PG8_SCHED;
            PG8_LDA(At, 0, 1); PG8_STAGE(PG8_SB(0, 0), b2, voffB); PG8_STAGE(PG8_SB(0, 1), b2 + hsB, voffB); PG8_STAGE(PG8_SA(0, 0), a2, voffA);
            PG8_WAIT_V(8); PG8_WAIT_L(0); PG8_BAR; PG8_MMA(1, 0, At, B0); if (b1on) PG8_MMA(1, 1, At, B1); PG8_BAR; PG8_SCHED;
            PG8_LDB(B0, 1, 0); PG8_LDB(B1, 1, 1); PG8_SCHED; PG8_LDA(At, 1, 0); PG8_STAGE(PG8_SA(0, 1), a2 + hsA, voffA);
            PG8_WAIT_V(8); PG8_WAIT_L(0); PG8_BAR; PG8_MMA(0, 0, At, B0); if (b1on) PG8_MMA(0, 1, At, B1); PG8_BAR; PG8_SCHED;
            PG8_LDA(At, 1, 1); PG8_STAGE(PG8_SB(1, 0), b3, voffB); PG8_STAGE(PG8_SB(1, 1), b3 + hsB, voffB); PG8_STAGE(PG8_SA(1, 0), a3, voffA);
            PG8_WAIT_V(8); PG8_WAIT_L(0); PG8_BAR; PG8_MMA(1, 0, At, B0); if (b1on) PG8_MMA(1, 1, At, B1); PG8_BAR; PG8_SCHED;
            } else {
            PG8_LDB(B0, 0, 0); PG8_SCHED; PG8_LDA(At, 0, 0); PG8_STAGE(PG8_SA(1, 1), a1 + hsA, voffA);
            PG8_WAIT_L(8); PG8_BAR; PG8_WAIT_L(0); PG8_MMA(0, 0, At, B0); PG8_BAR; PG8_SCHED;
            PG8_LDB(B1, 0, 1); PG8_STAGE(PG8_SB(0, 0), b2, voffB);
            PG8_BAR; PG8_WAIT_L(0); PG8_MMA(0, 1, At, B1); PG8_BAR;
            PG8_LDA(At, 0, 1); PG8_STAGE(PG8_SA(0, 0), a2, voffA);
            PG8_BAR; PG8_WAIT_L(0); PG8_MMA(1, 0, At, B0); PG8_BAR; PG8_SCHED;
            PG8_STAGE(PG8_SB(0, 1), b2 + hsB, voffB);
            PG8_WAIT_V(6); PG8_BAR; PG8_MMA(1, 1, At, B1); PG8_BAR;
            PG8_LDB(B0, 1, 0); PG8_SCHED; PG8_LDA(At, 1, 0); PG8_STAGE(PG8_SA(0, 1), a2 + hsA, voffA);
            PG8_WAIT_L(8); PG8_BAR; PG8_WAIT_L(0); PG8_MMA(0, 0, At, B0); PG8_BAR; PG8_SCHED;
            PG8_LDB(B1, 1, 1); PG8_STAGE(PG8_SB(1, 0), b3, voffB);
            PG8_BAR; PG8_WAIT_L(0); PG8_MMA(0, 1, At, B1); PG8_BAR;
            PG8_LDA(At, 1, 1); PG8_STAGE(PG8_SA(1, 0), a3, voffA);
            PG8_BAR; PG8_WAIT_L(0); PG8_MMA(1, 0, At, B0); PG8_BAR; PG8_SCHED;
            PG8_STAGE(PG8_SB(1, 1), b3 + hsB, voffB);
            PG8_WAIT_V(6); PG8_BAR; PG8_MMA(1, 1, At, B1); PG8_BAR;
            }
        }
        if constexpr (ALIGN_EPI) { if (wr == 0) PG8_BAR; }
        if constexpr (!Epi::AFTER_DRAIN) { E(acc, cur, wr, wc, fr, fq); S.done(cur); }
        if (!has_next) break;
#pragma unroll
        for (int a = 0; a < 2; ++a)
#pragma unroll
            for (int b = 0; b < 2; ++b)
#pragma unroll
                for (int m = 0; m < 4; ++m)
#pragma unroll
                    for (int n = 0; n < 2; ++n) acc[a][b][m][n] = (f32x4){0.f, 0.f, 0.f, 0.f};
        cur = nxt; cA = nA; cB = nB; ++ui;
        if constexpr (ALIGN_EPI) { if (wr == 1) PG8_BAR; }
    }
    PG8_WAIT_V(0);
    if constexpr (!ALIGN_EPI) { if (wr == 0) PG8_BAR; }
    PG8_BAR;
    if constexpr (Epi::AFTER_DRAIN) { E.fused(acc, cur, wr, wc, fr, fq, lds, wid, lane); S.done(cur); }
#undef PG8_SA
#undef PG8_SB
#undef PG8_STAGE
#undef PG8_LDA
#undef PG8_LDB
#undef PG8_MMA
#undef PG8_WAIT_V
#undef PG8_WAIT_L
#undef PG8_BAR
#undef PG8_SCHED
}
}
#define GAS __attribute__((address_space(1)))
#define LAS __attribute__((address_space(3)))
typedef unsigned short bf16;
typedef unsigned v4u __attribute__((ext_vector_type(4)));
typedef float f32x4 __attribute__((ext_vector_type(4)));
typedef short bf16x8 __attribute__((ext_vector_type(8)));
typedef GAS unsigned gu32;
typedef GAS unsigned long long gu64;
#define RLX_AGENT __ATOMIC_RELAXED, __HIP_MEMORY_SCOPE_AGENT
#define LDS_WAIT() asm volatile("s_waitcnt lgkmcnt(0)" ::: "memory")
#define VM_WAIT() asm volatile("s_waitcnt vmcnt(0)" ::: "memory")
__device__ __forceinline__ unsigned long long rt() { return __builtin_amdgcn_s_memrealtime(); }
__device__ __forceinline__ unsigned f2bf(float f) { unsigned u = __builtin_bit_cast(unsigned, f); return (u + 0x7fffu + ((u >> 16) & 1u)) >> 16; }
__device__ __forceinline__ unsigned pk2(float lo, float hi) { return f2bf(lo) | (f2bf(hi) << 16); }

#define XB_TMO      128
#define XB_XCNT(j)  (256  + 64 * (j))
#define XB_XSUB(j)  (1280 + 64 * (j))
#define XB_XGEN(j)  (2304 + 64 * (j))
#define XB_TOP      3328
#define XB_TOPGEN   3392
#define XCD_BAR_WORDS 3456
#define XB_SPIN_CAP (1u << 24)

__device__ __forceinline__ unsigned xb_ld(unsigned* p)              { return __hip_atomic_load(p, __ATOMIC_RELAXED, __HIP_MEMORY_SCOPE_AGENT); }
__device__ __forceinline__ unsigned xb_add(unsigned* p, unsigned v) { return __hip_atomic_fetch_add(p, v, __ATOMIC_RELAXED, __HIP_MEMORY_SCOPE_AGENT); }
__device__ __forceinline__ unsigned xb_xcc_id() { return (unsigned)__builtin_amdgcn_s_getreg((3 << 11) | 20) & 0xFu; }
#define XB_SPIN(cond, bar) do { unsigned _sp = 0; while (cond) { __builtin_amdgcn_s_sleep(1); \
    if ((++_sp & 255u) == 0u) { if (xb_ld(&(bar)[XB_TMO])) break; if (_sp > XB_SPIN_CAP) { atomicAdd(&(bar)[XB_TMO], 1u); break; } } } } while (0)

struct XcdBarrier {
    unsigned* bar; unsigned x;
    volatile LAS unsigned* st;
};

__device__ __forceinline__ XcdBarrier xcd_barrier_post(unsigned* bar, volatile LAS unsigned* st) {
    XcdBarrier b; b.bar = bar; b.x = xb_xcc_id(); b.st = st;
    if (threadIdx.x == 0) (void)xb_add(&bar[XB_XCNT(b.x)], 1u);
    return b;
}
__device__ __forceinline__ void xcd_barrier_complete(unsigned* bar, unsigned x, unsigned& nloc, unsigned& nx) {
    const unsigned G = gridDim.x * gridDim.y * gridDim.z;
    unsigned sum, cnt, mine, sp = 0u;
    for (;;) {
        sum = 0u; cnt = 0u; mine = 0u;
#pragma unroll
        for (unsigned j = 0; j < 16; ++j) { const unsigned c = xb_ld(&bar[XB_XCNT(j)]); sum += c; cnt += (c > 0u) ? 1u : 0u; mine = (j == x) ? c : mine; }
        if (sum == G) break;
        __builtin_amdgcn_s_sleep(1);
        if ((++sp & 255u) == 0u) { if (xb_ld(&bar[XB_TMO])) break; if (sp > XB_SPIN_CAP) { atomicAdd(&bar[XB_TMO], 1u); break; } }
    }
    nloc = mine > 0u ? mine : 1u; nx = cnt > 0u ? cnt : 1u;
}

__device__ __forceinline__ void xcd_barrier(const XcdBarrier& b) {
    asm volatile("s_waitcnt vmcnt(0)" ::: "memory");
    __syncthreads();
    if (threadIdx.x == 0) {
        unsigned* bar = b.bar;
        __builtin_amdgcn_s_waitcnt(0);
        unsigned nloc = b.st[0], nx = b.st[1];
        if (nloc == 0u) { xcd_barrier_complete(bar, b.x, nloc, nx); b.st[0] = nloc; b.st[1] = nx; }
        const unsigned old = xb_add(&bar[XB_XSUB(b.x)], 1u);
        const unsigned gen = old / nloc;
        if (old + 1u == (gen + 1u) * nloc) {
            __builtin_amdgcn_fence(__ATOMIC_RELEASE, "agent");
            asm volatile("s_waitcnt vmcnt(0)" ::: "memory");
            const unsigned og = xb_add(&bar[XB_TOP], 1u);
            const unsigned tg = og / nx;
            if (og + 1u == (tg + 1u) * nx) xb_add(&bar[XB_TOPGEN], 1u);
            else XB_SPIN(xb_ld(&bar[XB_TOPGEN]) == tg, bar);
            __builtin_amdgcn_fence(__ATOMIC_ACQUIRE, "agent");
            xb_add(&bar[XB_XGEN(b.x)], 1u);
            asm volatile("s_waitcnt vmcnt(0)" ::: "memory");
        } else {
            XB_SPIN(xb_ld(&bar[XB_XGEN(b.x)]) == gen, bar);
            __builtin_amdgcn_fence(__ATOMIC_ACQUIRE, "agent");
            asm volatile("s_waitcnt vmcnt(0)" ::: "memory");
        }
    }
    __syncthreads();
}
constexpr int NWAVES = 8, NTHREADS = 512;
constexpr int RING_OFF = 0, RING_BYTES = 131072, LDSCTL_OFF = RING_BYTES, MISC_OFF = LDSCTL_OFF + 320, LDS_BYTES = 163840;
typedef unsigned u32x2 __attribute__((ext_vector_type(2)));
typedef unsigned u32x4 __attribute__((ext_vector_type(4)));

__device__ __forceinline__ float bf2f(unsigned short b) { return __builtin_bit_cast(float, (unsigned)b << 16); }
__device__ __forceinline__ float bflo(unsigned w) { return __builtin_bit_cast(float, w << 16); }
__device__ __forceinline__ float bfhi(unsigned w) { return __builtin_bit_cast(float, w & 0xffff0000u); }
__device__ __forceinline__ float wave_sum(float v) {
#pragma unroll
    for (int o = 1; o < 64; o <<= 1) v += __shfl_xor(v, o);
    return v;
}
__device__ __forceinline__ float wave_max(float v) {
#pragma unroll
    for (int o = 1; o < 64; o <<= 1) v = fmaxf(v, __shfl_xor(v, o));
    return v;
}
__device__ __forceinline__ int wave_min_i(int v) {
#pragma unroll
    for (int o = 1; o < 64; o <<= 1) v = min(v, __shfl_xor(v, o));
    return v;
}

struct Frame {
    LAS unsigned char* lds;
    unsigned char* ldsg;
    int tid, lane, wave, vcu, G;
};

__device__ __forceinline__ void p0_transpose_item(const float* W, int K, int N, int Npad, bf16* WT, int row_off, LAS float* scr, int item, int lane) {
    const int nblk = Npad / 32, kb = item / nblk, nb = item % nblk, k0 = 64 * kb, n0 = 32 * nb;
    const int ncol = n0 + (lane & 31);
    float tv[32];
#pragma unroll
    for (int i = 0; i < 32; ++i) { const int kk = 2 * i + (lane >> 5); tv[i] = (ncol < N) ? __builtin_nontemporal_load(W + (size_t)(k0 + kk) * N + ncol) : 0.f; }
#pragma unroll
    for (int i = 0; i < 32; ++i) { const int kk = 2 * i + (lane >> 5); scr[kk * 33 + (lane & 31)] = tv[i]; }
    LDS_WAIT(); asm volatile("" ::: "memory");
    const int c = lane & 7;
#pragma unroll
    for (int j = 0; j < 4; ++j) { const int n = (lane >> 3) + 8 * j; const LAS float* s = scr + (8 * c) * 33 + n;
        v4u o; o.x = pk2(s[0 * 33], s[1 * 33]); o.y = pk2(s[2 * 33], s[3 * 33]); o.z = pk2(s[4 * 33], s[5 * 33]); o.w = pk2(s[6 * 33], s[7 * 33]);
        *(GAS v4u*)(WT + (size_t)(row_off + n0 + n) * K + k0 + 8 * c) = o; }
    LDS_WAIT(); asm volatile("" ::: "memory");
}
__device__ __forceinline__ void p0_transpose_item_ln(const float* W, bf16* WT, LAS float* scr, int item, int lane, const float* g, const float* b, float* csum, float* bvec) {
    constexpr int K = 2048, N = 2048; const int nblk = N / 32, kb = item / nblk, nb = item % nblk, k0 = 64 * kb, n0 = 32 * nb;
    const int ncol = n0 + (lane & 31);
    float tv[32];
#pragma unroll
    for (int i = 0; i < 32; ++i) { const int kk = 2 * i + (lane >> 5); tv[i] = __builtin_nontemporal_load(W + (size_t)(k0 + kk) * N + ncol); }
    float cs = 0.f, bs = 0.f;
#pragma unroll
    for (int i = 0; i < 32; ++i) { const int kk = 2 * i + (lane >> 5); const float w = tv[i]; bs += w * b[k0 + kk];
        const float wr = __builtin_bit_cast(float, f2bf(w * g[k0 + kk]) << 16); cs += wr; scr[kk * 33 + (lane & 31)] = wr; }
    { auto r = __builtin_amdgcn_permlane32_swap(__float_as_uint(cs), __float_as_uint(cs), false, false); cs = __uint_as_float(r[0]) + __uint_as_float(r[1]); }
    { auto r = __builtin_amdgcn_permlane32_swap(__float_as_uint(bs), __float_as_uint(bs), false, false); bs = __uint_as_float(r[0]) + __uint_as_float(r[1]); }
    if (lane < 32) { csum[(size_t)kb * 2048 + ncol] = cs; bvec[(size_t)kb * 2048 + ncol] = bs; }
    LDS_WAIT(); asm volatile("" ::: "memory");
    const int c = lane & 7;
#pragma unroll
    for (int j = 0; j < 4; ++j) { const int n = (lane >> 3) + 8 * j; const LAS float* s = scr + (8 * c) * 33 + n;
        v4u o; o.x = pk2(s[0 * 33], s[1 * 33]); o.y = pk2(s[2 * 33], s[3 * 33]); o.z = pk2(s[4 * 33], s[5 * 33]); o.w = pk2(s[6 * 33], s[7 * 33]);
        *(GAS v4u*)(WT + (size_t)(n0 + n) * K + k0 + 8 * c) = o; }
    LDS_WAIT(); asm volatile("" ::: "memory");
}
__device__ __forceinline__ void cvt_stream(const Frame& F, const float* in, bf16* out, size_t n8, int widx, int nwork) {
    const size_t T = (size_t)nwork * NTHREADS;
    for (size_t i0 = (size_t)widx * NTHREADS + F.tid; i0 < n8; i0 += 4 * T) {
        f32x4 a[4], b[4];
#pragma unroll
        for (int u = 0; u < 4; ++u) { const size_t i = i0 + u * T; if (i < n8) { a[u] = __builtin_nontemporal_load((const f32x4*)in + 2 * i); b[u] = __builtin_nontemporal_load((const f32x4*)in + 2 * i + 1); } }
#pragma unroll
        for (int u = 0; u < 4; ++u) { const size_t i = i0 + u * T; if (i < n8) {
            v4u w; w.x = pk2(a[u].x, a[u].y); w.y = pk2(a[u].z, a[u].w); w.z = pk2(b[u].x, b[u].y); w.w = pk2(b[u].z, b[u].w);
            ((v4u*)out)[i] = w; } }
    }
}
__device__ __forceinline__ void cvt_rows_fp4(const Frame& F, const float* tab, unsigned char* t4, float* inv_scale, int row_begin, int row_end, int widx, int nwork);
__device__ __forceinline__ void p0_first(const Frame& F, const float* x, const float* w_in, bf16* XB, bf16* WinT) {
    LAS float* scr = (LAS float*)(F.lds + RING_OFF + F.wave * 16384);
    const int gw = F.vcu * NWAVES + F.wave, NGW = F.G * NWAVES;
    constexpr int I_IN = (2048 / 64) * (D_IN_PAD / 32);
#pragma unroll 1
    for (int st = 0; st < 2; ++st) {
        if ((st == 0) == ((F.vcu & 1) == 0)) { for (int it = gw; it < I_IN; it += NGW) p0_transpose_item(w_in, 2048, D_IN, D_IN_PAD, WinT, 0, scr, it, F.lane); }
        else cvt_stream(F, x, XB, (size_t)M_TOK * 2048 / 8, F.vcu, F.G);
    }
}
__device__ __forceinline__ void p0_deferred(const Frame& F, int widx, int nwork, const float* pool_w, const float* w_out, const float* wq, bf16* PoolWT, bf16* WoutT, bf16* WqT,
                                            const float* g1, const float* b1, float* csum, float* bvec, const float* peer_sub, bf16* SKB,
                                            const float* peer_u, const float* peer_v, unsigned char* U8, float* ISU, float* ISV) {
    LAS float* scr = (LAS float*)(F.lds + RING_OFF + F.wave * 16384);
    const int gw = widx * NWAVES + F.wave, NGW = nwork * NWAVES;
    constexpr int I_SQ = (2048 / 64) * (2048 / 32), I_PG = (256 / 64) * (256 / 32);
    constexpr int NITEMS = 2 * I_SQ + 4 * I_PG;
    for (int it = gw; it < NITEMS; it += NGW) {
        int r = it;
        if (r < I_SQ) { p0_transpose_item(w_out, 2048, 2048, 2048, WoutT, 0, scr, r, F.lane); continue; } r -= I_SQ;
        if (r < I_SQ) { p0_transpose_item_ln(wq, WqT, scr, r, F.lane, g1, b1, csum, bvec); continue; } r -= I_SQ;
        const int g = r / I_PG; r -= g * I_PG;
        p0_transpose_item(pool_w + (size_t)g * 65536, 256, 256, 256, PoolWT, g * 256, scr, r, F.lane);
    }
    cvt_stream(F, peer_sub, SKB, (size_t)2 * 128 * 128 / 8, widx, nwork);
    cvt_rows_fp4(F, peer_u, U8, ISU, 0, N_EXPERTS, widx, nwork);
    cvt_rows_fp4(F, peer_v, U8 + 1024, ISV, 0, N_EXPERTS, widx, nwork);
}

__device__ __forceinline__ void ln1_fold_reduce(const Frame& F, const float* csp, const float* bvp, float* csum, float* bvec) {
    const int n = F.vcu * NTHREADS + F.tid;
    if (n < 2048) { float a = 0.f, b = 0.f;
#pragma unroll 8
        for (int kb = 0; kb < 32; ++kb) { a += csp[(size_t)kb * 2048 + n]; b += bvp[(size_t)kb * 2048 + n]; }
        csum[n] = a; bvec[n] = b; }
}

template <int W> __device__ __forceinline__ void pool_item(const bf16* pv, bf16* pooled, int m0, int t0, int c8) {
    constexpr int NR = W + 15;
    v4u rv[NR];
#pragma unroll
    for (int k = 0; k < NR; ++k) { const int dt = k - (W - 1); rv[k] = (v4u){0u, 0u, 0u, 0u}; if (t0 + dt >= 0) rv[k] = *(const v4u*)(pv + (size_t)(m0 + dt) * 1024 + c8); }
    float s[8] = {0.f, 0.f, 0.f, 0.f, 0.f, 0.f, 0.f, 0.f};
#define PP_ADD(k_, sg_) do { const unsigned x_ = rv[k_].x, y_ = rv[k_].y, z_ = rv[k_].z, q_ = rv[k_].w; \
        s[0] += sg_ * bflo(x_); s[1] += sg_ * bfhi(x_); s[2] += sg_ * bflo(y_); s[3] += sg_ * bfhi(y_); s[4] += sg_ * bflo(z_); s[5] += sg_ * bfhi(z_); s[6] += sg_ * bflo(q_); s[7] += sg_ * bfhi(q_); } while (0)
#pragma unroll
    for (int k = 0; k < W - 1; ++k) PP_ADD(k, 1.f);
#pragma unroll
    for (int i = 0; i < 16; ++i) {
        PP_ADD(W - 1 + i, 1.f);
        if (i >= 1) PP_ADD(i - 1, -1.f);
        const int t = t0 + i; const float inv = 1.f / (float)(t + 1 < W ? t + 1 : W);
        const unsigned x_ = rv[W - 1 + i].x, y_ = rv[W - 1 + i].y, z_ = rv[W - 1 + i].z, q_ = rv[W - 1 + i].w;
        v4u o; o.x = pk2(s[0] * inv - bflo(x_), s[1] * inv - bfhi(x_)); o.y = pk2(s[2] * inv - bflo(y_), s[3] * inv - bfhi(y_));
        o.z = pk2(s[4] * inv - bflo(z_), s[5] * inv - bfhi(z_)); o.w = pk2(s[6] * inv - bflo(q_), s[7] * inv - bfhi(q_));
        *(v4u*)(pooled + (size_t)(m0 + i) * 1024 + c8) = o;
    }
#undef PP_ADD
}
__device__ __forceinline__ void phase_pool_prep(const Frame& F, const bf16* pv, bf16* pooled) {
    const int total = (M_TOK / 16) * 128;
    for (int i = F.vcu * NTHREADS + F.tid; i < total; i += F.G * NTHREADS) {
        const int tb = i >> 7, c8 = (i & 127) * 8, m0 = tb * 16, t0 = m0 & (SEQ - 1);
        switch (c8 >> 8) {
            case 0: pool_item<2>(pv, pooled, m0, t0, c8); break;
            case 1: pool_item<4>(pv, pooled, m0, t0, c8); break;
            case 2: pool_item<8>(pv, pooled, m0, t0, c8); break;
            default: pool_item<16>(pv, pooled, m0, t0, c8); break;
        }
    }
}

__device__ __forceinline__ unsigned sortable(float f) { const unsigned u = __builtin_bit_cast(unsigned, f); return u ^ ((unsigned)((int)u >> 31) | 0x80000000u); }

__device__ __forceinline__ void phase_indexer_simple(const Frame& F, const bf16* qi, const bf16* kiwi, unsigned* mask) {
    float* qs = (float*)F.ldsg;
    float* wsh = qs + 1024;
    unsigned* keys = (unsigned*)(wsh + 16);
    unsigned* cnt_sh = keys + 4096;
    const int tid = F.tid;
    for (int m = F.vcu; m < M_TOK; m += F.G) {
        const int t = m & (SEQ - 1), b0 = m - t;
        for (int i = tid; i < 1024; i += NTHREADS) qs[i] = bf2f(qi[(size_t)m * 1024 + i]);
        if (tid < 16) wsh[tid] = bf2f(kiwi[(size_t)m * 256 + 64 + tid]);
        __syncthreads();
        const int n = t + 1;
        for (int s = tid; s < n; s += NTHREADS) {
            const v4u* kp = (const v4u*)(kiwi + (size_t)(b0 + s) * 256);
            float kf[64];
#pragma unroll
            for (int i = 0; i < 8; ++i) { const v4u w = kp[i];
                kf[8 * i + 0] = bflo(w.x); kf[8 * i + 1] = bfhi(w.x); kf[8 * i + 2] = bflo(w.y); kf[8 * i + 3] = bfhi(w.y);
                kf[8 * i + 4] = bflo(w.z); kf[8 * i + 5] = bfhi(w.z); kf[8 * i + 6] = bflo(w.w); kf[8 * i + 7] = bfhi(w.w); }
            float sc = 0.f;
#pragma unroll 1
            for (int h = 0; h < 16; ++h) {
                float d = 0.f;
#pragma unroll
                for (int i = 0; i < 64; ++i) d = fmaf(qs[h * 64 + i], kf[i], d);
                sc = fmaf(wsh[h], fmaxf(d, 0.f), sc);
            }
            keys[s] = sortable(sc);
        }
        __syncthreads();
        unsigned tau = 0u; int need_ties = 0; const bool all = (n <= TOPK);
        if (!all) {
            unsigned prefix = 0u;
#pragma unroll 1
            for (int bit = 31; bit >= 0; --bit) {
                const unsigned cand = prefix | (1u << bit);
                if (tid == 0) *cnt_sh = 0u;
                __syncthreads();
                int c = 0;
                for (int s = tid; s < n; s += NTHREADS) c += (keys[s] >= cand) ? 1 : 0;
                c = (int)wave_sum((float)c);
                if ((tid & 63) == 0) atomicAdd(cnt_sh, (unsigned)c);
                __syncthreads();
                if (*cnt_sh >= (unsigned)TOPK) prefix = cand;
                __syncthreads();
            }
            tau = prefix;
            if (tid == 0) *cnt_sh = 0u;
            __syncthreads();
            int c = 0;
            for (int s = tid; s < n; s += NTHREADS) c += (keys[s] > tau) ? 1 : 0;
            c = (int)wave_sum((float)c);
            if ((tid & 63) == 0) atomicAdd(cnt_sh, (unsigned)c);
            __syncthreads();
            need_ties = TOPK - (int)*cnt_sh;
        }
        for (int s0 = 0; s0 < SEQ; s0 += NTHREADS) {
            const int s = s0 + tid;
            bool sel = false;
            if (s < n) {
                if (all) sel = true;
                else {
                    const unsigned k = keys[s];
                    if (k > tau) sel = true;
                    else if (k == tau) { int r = 0; for (int s2 = 0; s2 < s; ++s2) r += (keys[s2] == tau) ? 1 : 0; sel = r < need_ties; }
                }
            }
            const unsigned long long bal = __ballot(sel);
            if ((tid & 63) == 0) { const int w = s >> 5; mask[(size_t)m * 128 + w] = (unsigned)bal; mask[(size_t)m * 128 + w + 1] = (unsigned)(bal >> 32); }
        }
        __syncthreads();
    }
}

__device__ __forceinline__ int t5_bucket(int dist) {
    if (dist < 16) return dist;
    const float d = (float)dist;
    const int large = 16 + (int)(logf(d / 16.f) / logf(8.f) * 16.f);
    return large < 31 ? large : 31;
}

__device__ __forceinline__ void phase_attn_simple(const Frame& F, const bf16* Q, const bf16* K, const bf16* V, const unsigned* mask, const float* rel_bias, bf16* mixin) {
    int* list = (int*)F.ldsg;
    float* qsh = (float*)(list + 256);
    float* bias2 = qsh + 1024;
    int* nsel_sh = (int*)(bias2 + 129 * 8);
    const int tid = F.tid, lane = F.lane, wid = F.wave;
    for (int i = tid; i < 129 * 8; i += NTHREADS) { const int d = i >> 3, h = i & 7; bias2[i] = rel_bias[t5_bucket(d) * 8 + h] * LOG2E; }
    for (int m = F.vcu; m < M_TOK; m += F.G) {
        const int t = m & (SEQ - 1), b0 = m - t;
        qsh[wid * 128 + lane] = bf2f(Q[(size_t)m * 1024 + wid * 128 + lane]);
        qsh[wid * 128 + lane + 64] = bf2f(Q[(size_t)m * 1024 + wid * 128 + 64 + lane]);
        if (wid == 0) {
            const unsigned w0 = mask[(size_t)m * 128 + 2 * lane], w1 = mask[(size_t)m * 128 + 2 * lane + 1];
            unsigned long long bits = (unsigned long long)w0 | ((unsigned long long)w1 << 32);
            const int c = __popcll(bits);
            int incl = c;
#pragma unroll
            for (int o = 1; o < 64; o <<= 1) { const int v = __shfl_up(incl, o); if (lane >= o) incl += v; }
            int off = incl - c;
            while (bits) { const int pos = __ffsll((long long)bits) - 1; bits &= bits - 1; if (off < 256) list[off] = 64 * lane + pos; ++off; }
            if (lane == 63) *nsel_sh = incl < 256 ? incl : 256;
        }
        __syncthreads();
        const int nsel = *nsel_sh, h = wid;
        float lg[4]; int sidx[4];
#pragma unroll
        for (int j = 0; j < 4; ++j) {
            const int idx = lane + 64 * j;
            lg[j] = -INFINITY; sidx[j] = 0;
            if (idx < nsel) {
                const int s = list[idx]; sidx[j] = s;
                const v4u* kp = (const v4u*)(K + (size_t)(b0 + s) * 1024 + h * 128);
                float d = 0.f;
#pragma unroll
                for (int i = 0; i < 16; ++i) { const v4u w = kp[i]; const float* qq = &qsh[h * 128 + 8 * i];
                    d = fmaf(qq[0], bflo(w.x), d); d = fmaf(qq[1], bfhi(w.x), d); d = fmaf(qq[2], bflo(w.y), d); d = fmaf(qq[3], bfhi(w.y), d);
                    d = fmaf(qq[4], bflo(w.z), d); d = fmaf(qq[5], bfhi(w.z), d); d = fmaf(qq[6], bflo(w.w), d); d = fmaf(qq[7], bfhi(w.w), d); }
                const int dist = t - s;
                lg[j] = d + bias2[(dist < 128 ? dist : 128) * 8 + h];
            }
        }
        float mx = fmaxf(fmaxf(lg[0], lg[1]), fmaxf(lg[2], lg[3])); mx = wave_max(mx);
        float pr[4], ps = 0.f;
#pragma unroll
        for (int j = 0; j < 4; ++j) { pr[j] = exp2f(lg[j] - mx); ps += pr[j]; }
        ps = wave_sum(ps);
        float o0 = 0.f, o1 = 0.f;
        for (int i = 0; i < nsel; ++i) {
            const int j = i >> 6, src = i & 63;
            const float pj = (j == 0) ? pr[0] : (j == 1) ? pr[1] : (j == 2) ? pr[2] : pr[3];
            const int sj = (j == 0) ? sidx[0] : (j == 1) ? sidx[1] : (j == 2) ? sidx[2] : sidx[3];
            const float p = __shfl(pj, src); const int s = __shfl(sj, src);
            const unsigned w = *(const unsigned*)(V + (size_t)(b0 + s) * 1024 + h * 128 + 2 * lane);
            o0 = fmaf(p, bflo(w), o0); o1 = fmaf(p, bfhi(w), o1);
        }
        const float inv = 1.f / ps;
        *(unsigned*)(mixin + (size_t)m * 2048 + 1024 + h * 128 + 2 * lane) = pk2(o0 * inv, o1 * inv);
        __syncthreads();
    }
}

__device__ __forceinline__ float wsum_dpp(float v) {
    v += __builtin_amdgcn_update_dpp(0.f, v, 0xB1, 0xf, 0xf, true);
    v += __builtin_amdgcn_update_dpp(0.f, v, 0x4E, 0xf, 0xf, true);
    v += __builtin_amdgcn_update_dpp(0.f, v, 0x141, 0xf, 0xf, true);
    v += __builtin_amdgcn_update_dpp(0.f, v, 0x140, 0xf, 0xf, true);
    v += __builtin_amdgcn_update_dpp(0.f, v, 0x142, 0xa, 0xf, false);
    v += __builtin_amdgcn_update_dpp(0.f, v, 0x143, 0xc, 0xf, false);
    return __builtin_bit_cast(float, __builtin_amdgcn_readlane(__builtin_bit_cast(int, v), 63));
}
__device__ __forceinline__ void phase_ln1(const Frame& F, const bf16* z, bf16* hb, const float* g, const float* bta, const float* stats) {
    const int lane = F.lane, NGW = F.G * NWAVES;
    int row = F.vcu * NWAVES + F.wave;
    v4u cur[4], nx[4];
    if (row < M_TOK) { const v4u* zr = (const v4u*)(z + (size_t)row * 2048) + lane;
#pragma unroll
        for (int j = 0; j < 4; ++j) cur[j] = zr[64 * j]; }
#pragma unroll 1
    for (; row < M_TOK; row += NGW) {
        const int rn = row + NGW;
        if (rn < M_TOK) { const v4u* zr = (const v4u*)(z + (size_t)rn * 2048) + lane;
#pragma unroll
            for (int j = 0; j < 4; ++j) nx[j] = zr[64 * j]; }
        float v[4][8]; float s = 0.f;
#pragma unroll
        for (int j = 0; j < 4; ++j) { const unsigned wx = cur[j].x, wy = cur[j].y, wz = cur[j].z, ww = cur[j].w;
            v[j][0] = bflo(wx); v[j][1] = bfhi(wx); v[j][2] = bflo(wy); v[j][3] = bfhi(wy); v[j][4] = bflo(wz); v[j][5] = bfhi(wz); v[j][6] = bflo(ww); v[j][7] = bfhi(ww);
#pragma unroll
            for (int i = 0; i < 8; ++i) s += v[j][i]; }
        const float mean = stats[2 * row] * (1.f / 2048.f); (void)s;
#pragma unroll
        for (int j = 0; j < 4; ++j)
#pragma unroll
            for (int i = 0; i < 8; ++i) v[j][i] -= mean;
        const float rstd = 1.f / sqrtf(fmaxf(stats[2 * row + 1] * (1.f / 2048.f) - mean * mean, 0.f) + LN_EPS);
        v4u* ob = (v4u*)(hb + (size_t)row * 2048) + lane;
#pragma unroll
        for (int j = 0; j < 4; ++j) { const int e = 8 * (lane + 64 * j);
            const f32x4 g0 = *(const f32x4*)(g + e), g1 = *(const f32x4*)(g + e + 4), b0 = *(const f32x4*)(bta + e), b1 = *(const f32x4*)(bta + e + 4);
            v4u w; w.x = pk2(v[j][0] * rstd * g0.x + b0.x, v[j][1] * rstd * g0.y + b0.y); w.y = pk2(v[j][2] * rstd * g0.z + b0.z, v[j][3] * rstd * g0.w + b0.w);
            w.z = pk2(v[j][4] * rstd * g1.x + b1.x, v[j][5] * rstd * g1.y + b1.y); w.w = pk2(v[j][6] * rstd * g1.z + b1.z, v[j][7] * rstd * g1.w + b1.w);
            ob[64 * j] = w; }
#pragma unroll
        for (int j = 0; j < 4; ++j) cur[j] = nx[j];
    }
}

typedef float f32x16 __attribute__((ext_vector_type(16)));
typedef float f32x2 __attribute__((ext_vector_type(2)));
__device__ __forceinline__ float unsortable(unsigned k) { const unsigned u = (k & 0x80000000u) ? (k ^ 0x80000000u) : ~k; return __builtin_bit_cast(float, u); }
__device__ __forceinline__ void ce_d(unsigned& a, unsigned& b) { const unsigned mx = a > b ? a : b, mn = a > b ? b : a; a = mx; b = mn; }
__device__ __forceinline__ void ce_dp(unsigned& ka, unsigned& pa, unsigned& kb, unsigned& pb) {
    const bool sw = kb > ka; const unsigned nka = sw ? kb : ka, nkb = sw ? ka : kb, npa = sw ? pb : pa, npb = sw ? pa : pb; ka = nka; kb = nkb; pa = npa; pb = npb; }
template <int BASE, int N> __device__ __forceinline__ void sort16_desc(unsigned (&v)[N]) {
#pragma unroll
    for (int k = 2; k <= 16; k <<= 1)
#pragma unroll
        for (int j = k >> 1; j > 0; j >>= 1)
#pragma unroll
            for (int i = 0; i < 16; ++i) { const int l = i ^ j; if (l > i) { if ((i & k) == 0) ce_d(v[BASE + i], v[BASE + l]); else ce_d(v[BASE + l], v[BASE + i]); } }
}
template <int A, int B, int N> __device__ __forceinline__ void merge16_desc(unsigned (&v)[N]) {
#pragma unroll
    for (int i = 0; i < 16; ++i) v[A + i] = v[A + i] > v[B + 15 - i] ? v[A + i] : v[B + 15 - i];
#pragma unroll
    for (int j = 8; j > 0; j >>= 1)
#pragma unroll
        for (int i = 0; i < 16; ++i) { const int l = i ^ j; if (l > i) ce_d(v[A + i], v[A + l]); }
}
template <int BASE, int N> __device__ __forceinline__ void sort16_desc_p(unsigned (&v)[N], unsigned (&p)[N]) {
#pragma unroll
    for (int k = 2; k <= 16; k <<= 1)
#pragma unroll
        for (int j = k >> 1; j > 0; j >>= 1)
#pragma unroll
            for (int i = 0; i < 16; ++i) { const int l = i ^ j; if (l > i) { if ((i & k) == 0) ce_dp(v[BASE + i], p[BASE + i], v[BASE + l], p[BASE + l]); else ce_dp(v[BASE + l], p[BASE + l], v[BASE + i], p[BASE + i]); } }
}
template <int A, int B, int N> __device__ __forceinline__ void merge16_desc_p(unsigned (&v)[N], unsigned (&p)[N]) {
#pragma unroll
    for (int i = 0; i < 16; ++i) { const bool sw = v[B + 15 - i] > v[A + i]; v[A + i] = sw ? v[B + 15 - i] : v[A + i]; p[A + i] = sw ? p[B + 15 - i] : p[A + i]; }
#pragma unroll
    for (int j = 8; j > 0; j >>= 1)
#pragma unroll
        for (int i = 0; i < 16; ++i) { const int l = i ^ j; if (l > i) ce_dp(v[A + i], p[A + i], v[A + l], p[A + l]); }
}
constexpr int PEER_L_CTAB = 0, PEER_L_WSCR = 256, PEER_L_SK = 32768, PEER_L_G2 = 98304, PEER_L_B2 = 106496, PEER_L_G1 = 114688, PEER_L_B1 = 122880;
__device__ __forceinline__ void peer_half_top16(LAS const unsigned char* sk_half  , const char* qbase  , unsigned qoff, int r32, int kh, unsigned (&k)[64]) {
    f32x16 acc[4];
#pragma unroll
    for (int mt = 0; mt < 4; ++mt) acc[mt] = (f32x16){0.f, 0.f, 0.f, 0.f, 0.f, 0.f, 0.f, 0.f, 0.f, 0.f, 0.f, 0.f, 0.f, 0.f, 0.f, 0.f};
    const unsigned rowb = (unsigned)r32 * 256u, sw = (unsigned)(r32 & 15);
    bf16x8 bq[8];
#pragma unroll
    for (int ks = 0; ks < 8; ++ks) bq[ks] = *(const bf16x8*)((qbase + qoff) + 32 * ks);
#pragma unroll
    for (int ks = 0; ks < 8; ++ks) {
        const bf16x8 b = bq[ks];
        const unsigned ch = (((unsigned)(2 * ks + kh)) ^ sw) << 4;
#pragma unroll
        for (int mt = 0; mt < 4; ++mt) {
            const bf16x8 a = *(LAS const bf16x8*)(sk_half + mt * 8192 + rowb + ch);
            acc[mt] = __builtin_amdgcn_mfma_f32_32x32x16_bf16(a, b, acc[mt], 0, 0, 0);
        }
    }
#pragma unroll
    for (int mt = 0; mt < 4; ++mt)
#pragma unroll
        for (int r = 0; r < 16; ++r) { const int key = 32 * mt + (r & 3) + 8 * (r >> 2);
            k[16 * mt + r] = (sortable(acc[mt][r]) & ~0x7Fu) | (unsigned)(127 - key - 4 * kh); }
    sort16_desc<0>(k); sort16_desc<16>(k); sort16_desc<32>(k); sort16_desc<48>(k);
    merge16_desc<0, 16>(k); merge16_desc<32, 48>(k); merge16_desc<0, 32>(k);
    unsigned lo[16], hi[16];
#pragma unroll
    for (int i = 0; i < 16; ++i) { auto rr = __builtin_amdgcn_permlane32_swap(k[i], k[i], false, false); lo[i] = rr[0]; hi[i] = rr[1]; }
#pragma unroll
    for (int i = 0; i < 16; ++i) k[i] = lo[i] > hi[15 - i] ? lo[i] : hi[15 - i];
#pragma unroll
    for (int j = 8; j > 0; j >>= 1)
#pragma unroll
        for (int i = 0; i < 16; ++i) { const int l = i ^ j; if (l > i) ce_d(k[i], k[l]); }
}
__device__ __forceinline__ constexpr int peer_cbase(int i) { int s = 0; for (int t = 0; t < i; ++t) s += 16 / (t + 1); return s; }

__device__ __forceinline__ void peer_topk_tile(const Frame& F, int m0, const bf16* qp, int* eidx, float* gate) {
    int lane; asm volatile("v_mbcnt_lo_u32_b32 %0, -1, 0\n\tv_mbcnt_hi_u32_b32 %0, -1, %0" : "=v"(lane));
    const int r32 = lane & 31, kh = lane >> 5, hd = F.wave;
    LAS const unsigned* ctab = (LAS const unsigned*)(F.lds + PEER_L_CTAB);
    LAS unsigned char* wscr = F.lds + PEER_L_WSCR + F.wave * 2048;
    const char* qbase = (const char*)(qp + (size_t)m0 * 2048 + hd * 256);
    const unsigned qoff = (unsigned)(r32 * 2048 + 8 * kh) * 2u;
    unsigned k1[64], k2[64];
    peer_half_top16(F.lds + PEER_L_SK, qbase, qoff, r32, kh, k1);
    __builtin_amdgcn_sched_barrier(0);
    peer_half_top16(F.lds + PEER_L_SK + 32768, qbase + 256, qoff, r32, kh, k2);
    __builtin_amdgcn_sched_barrier(0);
    float v1[16], v2[16];
#pragma unroll
    for (int i = 0; i < 16; ++i) { v1[i] = unsortable(k1[i] & ~0x7Fu); v2[i] = unsortable(k2[i] & ~0x7Fu);
        wscr[i * 64 + lane] = (unsigned char)(127u - (k1[i] & 0x7Fu)); wscr[(16 + i) * 64 + lane] = (unsigned char)(127u - (k2[i] & 0x7Fu)); }
    unsigned ck[64];
#pragma unroll
    for (int i = 0; i < 16; ++i)
#pragma unroll
        for (int j = 0; j < 16; ++j)
            if ((i + 1) * (j + 1) <= 16) { const int cid = peer_cbase(i) + j; ck[cid] = (sortable(v1[i] + v2[j]) & ~0x3Fu) | (unsigned)(63 - cid); }
#pragma unroll
    for (int c = 50; c < 64; ++c) ck[c] = 0u;
    __builtin_amdgcn_sched_barrier(0);
    sort16_desc<0>(ck); sort16_desc<16>(ck); sort16_desc<32>(ck); sort16_desc<48>(ck);
    merge16_desc<0, 16>(ck); merge16_desc<32, 48>(ck); merge16_desc<0, 32>(ck);
    float ex[16], es = 0.f; const float s0 = unsortable(ck[0] & ~0x3Fu);
    unsigned ee[16];
    asm volatile("s_waitcnt lgkmcnt(0)" ::: "memory");
#pragma unroll
    for (int i = 0; i < 16; ++i) { ex[i] = __builtin_amdgcn_exp2f((unsortable(ck[i] & ~0x3Fu) - s0) * LOG2E); es += ex[i];
        const unsigned ij = ctab[63u - (ck[i] & 0x3Fu)];
        ee[i] = (unsigned)wscr[(ij >> 4) * 64 + lane] * 128u + (unsigned)wscr[(16 + (ij & 15u)) * 64 + lane]; }
    const float inv = 1.f / es;
    if (kh == 0) {
        char* ep = (char*)(eidx + (size_t)m0 * 128 + hd * 16); char* gp = (char*)(gate + (size_t)m0 * 128 + hd * 16); const unsigned ro = (unsigned)r32 * 512u;
#pragma unroll
        for (int q = 0; q < 4; ++q) { *(v4u*)((ep + ro) + 16 * q) = (v4u){ee[4 * q], ee[4 * q + 1], ee[4 * q + 2], ee[4 * q + 3]};
            *(f32x4*)((gp + ro) + 16 * q) = (f32x4){ex[4 * q] * inv, ex[4 * q + 1] * inv, ex[4 * q + 2] * inv, ex[4 * q + 3] * inv}; }
    }
    asm volatile("s_waitcnt lgkmcnt(0)" ::: "memory");
}

__device__ __forceinline__ float wave_sum_dpp(float v) {
    v += __builtin_amdgcn_update_dpp(0.f, v, 0xB1, 0xf, 0xf, true);
    v += __builtin_amdgcn_update_dpp(0.f, v, 0x4E, 0xf, 0xf, true);
    v += __builtin_amdgcn_update_dpp(0.f, v, 0x141, 0xf, 0xf, true);
    v += __builtin_amdgcn_update_dpp(0.f, v, 0x140, 0xf, 0xf, true);
    v += __builtin_amdgcn_update_dpp(0.f, v, 0x142, 0xa, 0xf, false);
    v += __builtin_amdgcn_update_dpp(0.f, v, 0x143, 0xc, 0xf, false);
    return __builtin_bit_cast(float, __builtin_amdgcn_readlane(__builtin_bit_cast(int, v), 63));
}
__device__ __forceinline__ float gelu_exact(float x) { return 0.5f * x * (1.f + erff(x * 0.7071067811865476f)); }
__device__ __forceinline__ int rdlane_i(int v, int l) { return __builtin_amdgcn_readlane(v, l); }
__device__ __forceinline__ float rdlane_f(float v, int l) { return __builtin_bit_cast(float, __builtin_amdgcn_readlane(__builtin_bit_cast(int, v), l)); }

typedef __bf16 bf16x2_t __attribute__((ext_vector_type(2)));
__device__ __forceinline__ void peer_tokens(const Frame& F, int m0, int ntok, const bf16* zb, const float* stats, float* outp, const int* eidx, const float* gate, const unsigned char* uv4, const float* isu, const float* isv) {
    int lane; asm volatile("v_mbcnt_lo_u32_b32 %0, -1, 0\n\tv_mbcnt_hi_u32_b32 %0, -1, %0" : "=v"(lane));
    const unsigned l4 = (unsigned)lane * 4u, l128 = (unsigned)lane * 128u, l16 = (unsigned)lane * 16u;
    int e0, e1; float cf0, cf1, su0, su1;
#define PF_ROUTE_E(m_, ea_, eb_) do { const char* ebp_ = (const char*)(eidx + (size_t)(m_) * 128); unsigned o4_ = l16 >> 2; asm volatile("" : "+v"(o4_));   \
        ea_ = *(const int*)(ebp_ + o4_); eb_ = *(const int*)((ebp_ + o4_) + 256); } while (0)
#define PF_ROUTE_F(m_) do { const char* gbp_ = (const char*)(gate + (size_t)(m_) * 128);   \
        unsigned o4_ = l16 >> 2; asm volatile("" : "+v"(o4_)); cf0 = *(const float*)(gbp_ + o4_) * isv[e0]; cf1 = *(const float*)((gbp_ + o4_) + 256) * isv[e1]; su0 = isu[e0]; su1 = isu[e1]; } while (0)
    PF_ROUTE_E(m0, e0, e1); PF_ROUTE_F(m0);
    v4u hv[4];
#define PF_HREC(m_) do { const int mh_ = (m_); const char* zrow = (const char*)(zb + (size_t)mh_ * 2048); \
    _Pragma("unroll") \
    for (int q = 0; q < 4; ++q) { unsigned l8 = l16 / 2; asm volatile("" : "+v"(l8)); const uint2 za = *(const uint2*)((zrow + l8) + 1024 * q), zb2 = *(const uint2*)((zrow + l8) + (1024 * q + 512)); \
        hv[q] = (v4u){za.x, za.y, zb2.x, zb2.y}; } \
    { float mean, rstd; pg8::ln1_row_stats(stats, mh_, mean, rstd); \
      unsigned gl_ = l16 + (unsigned)PEER_L_G2; asm volatile("" : "+v"(gl_)); LAS const unsigned char* gl = F.lds + gl_; \
    _Pragma("unroll") \
      for (int q = 0; q < 4; ++q) { const unsigned zx = hv[q].x, zy = hv[q].y, zz = hv[q].z, zw = hv[q].w; \
          const f32x4 ga = *(LAS const f32x4*)(gl + ((PEER_L_G1 - PEER_L_G2) + (2 * q) * 1024)), gb2 = *(LAS const f32x4*)(gl + ((PEER_L_G1 - PEER_L_G2) + (2 * q + 1) * 1024)); \
          const f32x4 ba = *(LAS const f32x4*)(gl + ((PEER_L_B1 - PEER_L_G2) + (2 * q) * 1024)), bb2 = *(LAS const f32x4*)(gl + ((PEER_L_B1 - PEER_L_G2) + (2 * q + 1) * 1024)); \
          v4u h; h.x = pk2((bflo(zx) - mean) * rstd * ga.x + ba.x, (bfhi(zx) - mean) * rstd * ga.y + ba.y); h.y = pk2((bflo(zy) - mean) * rstd * ga.z + ba.z, (bfhi(zy) - mean) * rstd * ga.w + ba.w); \
          h.z = pk2((bflo(zz) - mean) * rstd * gb2.x + bb2.x, (bfhi(zz) - mean) * rstd * gb2.y + bb2.y); h.w = pk2((bflo(zw) - mean) * rstd * gb2.z + bb2.z, (bfhi(zw) - mean) * rstd * gb2.w + bb2.w); \
          asm volatile("" : "+v"(h.x), "+v"(h.y), "+v"(h.z), "+v"(h.w)); \
          hv[q] = h; } } } while (0)
    PF_HREC(m0);
    __builtin_amdgcn_sched_barrier(0);
    f32x2 acc[16];
#pragma unroll
    for (int i = 0; i < 16; ++i) acc[i] = (f32x2){0.f, 0.f};
    v4u bu[16], bv[16];
#define PF_ROW(s_, j_) do { const int jj_ = (j_); const int e_ = (jj_ < 64) ? rdlane_i(e0, jj_ & 63) : rdlane_i(e1, jj_ & 63); \
        const unsigned char* rp_ = uv4 + (size_t)e_ * 2048; unsigned lo_ = l16; asm volatile("" : "+v"(lo_)); bu[s_] = *(const v4u*)(rp_ + lo_); bv[s_] = *(const v4u*)((rp_ + lo_) + 1024); } while (0)
#define PF_D4(w_, hq_) do { const unsigned hx_ = (hq_).x, hy_ = (hq_).y, hz_ = (hq_).z, hw_ = (hq_).w; \
        d_s = __builtin_amdgcn_fdot2_f32_bf16(__builtin_amdgcn_cvt_scalef32_pk_bf16_fp4((w_), 1.0f, 0), __builtin_bit_cast(bf16x2_t, hx_), d_s, false); \
        d_t = __builtin_amdgcn_fdot2_f32_bf16(__builtin_amdgcn_cvt_scalef32_pk_bf16_fp4((w_), 1.0f, 1), __builtin_bit_cast(bf16x2_t, hy_), d_t, false); \
        d_s = __builtin_amdgcn_fdot2_f32_bf16(__builtin_amdgcn_cvt_scalef32_pk_bf16_fp4((w_), 1.0f, 2), __builtin_bit_cast(bf16x2_t, hz_), d_s, false); \
        d_t = __builtin_amdgcn_fdot2_f32_bf16(__builtin_amdgcn_cvt_scalef32_pk_bf16_fp4((w_), 1.0f, 3), __builtin_bit_cast(bf16x2_t, hw_), d_t, false); } while (0)
#define PF_DOT(s_, dst_) do { float d_s = 0.f, d_t = 0.f; const unsigned wx_ = bu[s_].x, wy_ = bu[s_].y, wz_ = bu[s_].z, ww_ = bu[s_].w; \
        PF_D4(wx_, hv[0]); PF_D4(wy_, hv[1]); PF_D4(wz_, hv[2]); PF_D4(ww_, hv[3]); dst_ = wave_sum_dpp(d_s + d_t); } while (0)
#define PF_A4(w_, o_) do { \
        acc[(o_) + 0] += gg_ * __builtin_amdgcn_cvt_scalef32_pk_f32_fp4((w_), 1.0f, 0); acc[(o_) + 1] += gg_ * __builtin_amdgcn_cvt_scalef32_pk_f32_fp4((w_), 1.0f, 1); \
        acc[(o_) + 2] += gg_ * __builtin_amdgcn_cvt_scalef32_pk_f32_fp4((w_), 1.0f, 2); acc[(o_) + 3] += gg_ * __builtin_amdgcn_cvt_scalef32_pk_f32_fp4((w_), 1.0f, 3); } while (0)
#define PF_AXPY(s_, g_) do { const f32x2 gg_ = (f32x2){(g_), (g_)}; const unsigned wx_ = bv[s_].x, wy_ = bv[s_].y, wz_ = bv[s_].z, ww_ = bv[s_].w; \
        PF_A4(wx_, 0); PF_A4(wy_, 4); PF_A4(wz_, 8); PF_A4(ww_, 12); } while (0)
#define PF_BATCH(S0, j0_, jn_) do { const int j0v_ = (j0_); float av_ = 0.f; \
        _Pragma("unroll") for (int r_ = 0; r_ < 8; ++r_) { float d_; PF_DOT((S0) + r_, d_); if ((lane & 7) == r_) av_ = d_; } \
          \
        const int pj_ = j0v_ + (lane & 7); const int src_ = (pj_ & 63) << 2; \
        const float cfa_ = __builtin_bit_cast(float, __builtin_amdgcn_ds_bpermute(src_, __builtin_bit_cast(int, (j0v_ < 64) ? cf0 : cf1))); \
        const float sua_ = __builtin_bit_cast(float, __builtin_amdgcn_ds_bpermute(src_, __builtin_bit_cast(int, (j0v_ < 64) ? su0 : su1))); \
        const float gcv_ = cfa_ * gelu_exact(av_ * sua_); \
        _Pragma("unroll") for (int r_ = 0; r_ < 8; ++r_) { const float g_ = rdlane_f(gcv_, r_); PF_AXPY((S0) + r_, g_); if ((jn_) + r_ < 128) PF_ROW((S0) + r_, (jn_) + r_); } } while (0)
    int e0n = 0, e1n = 0;
#define PF_ROWN(s_, j_) do { const int jj_ = (j_); const int e_ = rdlane_i(e0n, jj_ & 63); \
        const unsigned char* rp_ = uv4 + (size_t)e_ * 2048; unsigned lo_ = l16; asm volatile("" : "+v"(lo_)); bu[s_] = *(const v4u*)(rp_ + lo_); bv[s_] = *(const v4u*)((rp_ + lo_) + 1024); } while (0)
#define PF_BATCHX(S0, j0_, jn_, NR_) do { const int j0v_ = (j0_); float av_ = 0.f; \
        _Pragma("unroll") for (int r_ = 0; r_ < 8; ++r_) { float d_; PF_DOT((S0) + r_, d_); if ((lane & 7) == r_) av_ = d_; } \
        const int pj_ = j0v_ + (lane & 7); const int src_ = (pj_ & 63) << 2; \
        const float cfa_ = __builtin_bit_cast(float, __builtin_amdgcn_ds_bpermute(src_, __builtin_bit_cast(int, cf1))); \
        const float sua_ = __builtin_bit_cast(float, __builtin_amdgcn_ds_bpermute(src_, __builtin_bit_cast(int, su1))); \
        const float gcv_ = cfa_ * gelu_exact(av_ * sua_); \
        _Pragma("unroll") for (int r_ = 0; r_ < 8; ++r_) { const float g_ = rdlane_f(gcv_, r_); PF_AXPY((S0) + r_, g_); if (more && r_ < (NR_)) PF_ROWN((S0) + r_, (jn_) + r_); } } while (0)
#pragma unroll
    for (int r = 0; r < 16; ++r) PF_ROW(r, r);
#pragma unroll 1
    for (int t = 0; t < ntok; ++t) {
        const int m = m0 + t; const bool more = t + 1 < ntok;
#pragma unroll 1
        for (int jb = 0; jb < 112; jb += 16) { PF_BATCH(0, jb, jb + 16); PF_BATCH(8, jb + 8, jb + 24); }
        if (more) PF_ROUTE_E(m + 1, e0n, e1n);
        PF_BATCHX(0, 112, 0, 8); PF_BATCHX(8, 120, 8, 4);
    __builtin_amdgcn_sched_barrier(0);
    float s = 0.f;
#pragma unroll
    for (int q = 0; q < 4; ++q) { const unsigned hx = hv[q].x, hy = hv[q].y, hz = hv[q].z, hw2 = hv[q].w;
        acc[4 * q + 0] = (f32x2){bflo(hx), bfhi(hx)} * ALPHA + acc[4 * q + 0]; acc[4 * q + 1] = (f32x2){bflo(hy), bfhi(hy)} * ALPHA + acc[4 * q + 1];
        acc[4 * q + 2] = (f32x2){bflo(hz), bfhi(hz)} * ALPHA + acc[4 * q + 2]; acc[4 * q + 3] = (f32x2){bflo(hw2), bfhi(hw2)} * ALPHA + acc[4 * q + 3];
        s += (acc[4 * q].x + acc[4 * q].y) + (acc[4 * q + 1].x + acc[4 * q + 1].y) + (acc[4 * q + 2].x + acc[4 * q + 2].y) + (acc[4 * q + 3].x + acc[4 * q + 3].y); }
    const float mean = wave_sum_dpp(s) * (1.f / 2048.f); float sq = 0.f;
#pragma unroll
    for (int i = 0; i < 16; ++i) { acc[i] = acc[i] - mean; sq += acc[i].x * acc[i].x + acc[i].y * acc[i].y; }
    const float rstd = 1.f / sqrtf(wave_sum_dpp(sq) * (1.f / 2048.f) + LN_EPS);
    char* orow = (char*)(outp + (size_t)m * 2048);
    unsigned lg2_; asm volatile("v_add_u32 %0, %1, %2" : "=v"(lg2_) : "v"(l16), "v"((unsigned)PEER_L_G2));
#pragma unroll
    for (int q = 0; q < 8; ++q) { const int eo = 16 * q;
        const f32x4 gg = *(LAS const f32x4*)((F.lds + lg2_) + q * 1024), bb = *(LAS const f32x4*)((F.lds + lg2_) + ((PEER_L_B2 - PEER_L_G2) + q * 1024));
        f32x4 o; o.x = acc[2 * q].x * rstd * gg.x + bb.x; o.y = acc[2 * q].y * rstd * gg.y + bb.y; o.z = acc[2 * q + 1].x * rstd * gg.z + bb.z; o.w = acc[2 * q + 1].y * rstd * gg.w + bb.w;
        unsigned o16_ = l16; asm volatile("" : "+v"(o16_)); *(f32x4*)((orow + o16_) + 1024 * q) = o; }
        __builtin_amdgcn_sched_barrier(0);
        if (more) { e0 = e0n; e1 = e1n;
#pragma unroll
            for (int r = 4; r < 8; ++r) PF_ROW(8 + r, 8 + r);
            PF_ROUTE_F(m + 1); PF_HREC(m + 1);
#pragma unroll
            for (int i = 0; i < 16; ++i) acc[i] = (f32x2){0.f, 0.f}; }
    }
#undef PF_ROW
#undef PF_ROWN
#undef PF_BATCHX
#undef PF_ROUTE_E
#undef PF_ROUTE_F
#undef PF_HREC
#undef PF_D4
#undef PF_DOT
#undef PF_A4
#undef PF_AXPY
#undef PF_BATCH
}

__device__ __forceinline__ void phase_peer_fast(const Frame& F, float* outp, const bf16* zb, const float* stats, const bf16* qp, const bf16* skb, int* eidx, float* gate,
                                                const unsigned char* uv4, const float* isu, const float* isv, const float* g2, const float* b2, const float* g1, const float* b1) {
    if (F.tid < 64) { unsigned v = 0u; int cid = 0;
        for (int i = 0; i < 16; ++i) for (int j = 0; j < 16; ++j) if ((i + 1) * (j + 1) <= 16) { if (cid == F.tid) v = (unsigned)(i * 16 + j); ++cid; }
        ((LAS unsigned*)(F.lds + PEER_L_CTAB))[F.tid] = v; }
    for (int c = F.tid; c < 2 * 128 * 16; c += NTHREADS) {
        const int row = c >> 4, ch = c & 15;
        const v4u w = *(const v4u*)(skb + (size_t)row * 128 + ch * 8);
        *(LAS v4u*)(F.lds + PEER_L_SK + row * 256 + ((ch ^ (row & 15)) << 4)) = w;
    }
    for (int c = F.tid; c < 512; c += NTHREADS) { const int src = 4 * c;
        *(LAS f32x4*)(F.lds + PEER_L_G2 + c * 16) = *(const f32x4*)(g2 + src); *(LAS f32x4*)(F.lds + PEER_L_B2 + c * 16) = *(const f32x4*)(b2 + src);
        *(LAS f32x4*)(F.lds + PEER_L_G1 + c * 16) = *(const f32x4*)(g1 + src); *(LAS f32x4*)(F.lds + PEER_L_B1 + c * 16) = *(const f32x4*)(b1 + src); }
    __syncthreads();
    const bool tilewise = (F.vcu & 1) != 0;
#pragma unroll 1
    for (int t0 = F.vcu; t0 < M_TOK / 32; t0 += (tilewise ? F.G : M_TOK)) {
#pragma unroll 1
        for (int tile = t0; tile < M_TOK / 32; tile += F.G) { peer_topk_tile(F, tile * 32, qp, eidx, gate); if (tilewise) break; }
        asm volatile("s_waitcnt vmcnt(0)" ::: "memory");
        __syncthreads();
        __builtin_amdgcn_sched_barrier(0);
#pragma unroll 1
        for (int tile = t0; tile < M_TOK / 32; tile += F.G) {
            peer_tokens(F, tile * 32 + F.wave * 4, 4, zb, stats, outp, eidx, gate, uv4, isu, isv);
            if (tilewise) break;
        }
    }
}

__device__ __forceinline__ float wave_max_dpp(float v) {
    v = fmaxf(v, __builtin_amdgcn_update_dpp(v, v, 0xB1, 0xf, 0xf, false));
    v = fmaxf(v, __builtin_amdgcn_update_dpp(v, v, 0x4E, 0xf, 0xf, false));
    v = fmaxf(v, __builtin_amdgcn_update_dpp(v, v, 0x141, 0xf, 0xf, false));
    v = fmaxf(v, __builtin_amdgcn_update_dpp(v, v, 0x140, 0xf, 0xf, false));
    v = fmaxf(v, __builtin_amdgcn_update_dpp(v, v, 0x142, 0xa, 0xf, false));
    v = fmaxf(v, __builtin_amdgcn_update_dpp(v, v, 0x143, 0xc, 0xf, false));
    return __builtin_bit_cast(float, __builtin_amdgcn_readlane(__builtin_bit_cast(int, v), 63));
}
__device__ __forceinline__ void cvt_rows_fp4(const Frame& F, const float* tab, unsigned char* t4  , float* inv_scale, int row_begin, int row_end, int widx, int nwork) {
    const int lane = F.lane; const int NGW = nwork * NWAVES;
    const int row0 = row_begin + widx * NWAVES + F.wave;
    f32x4 rg[4][8];
#define CV_LOAD(slot_, row_) do { const int rr_ = (row_); if (rr_ < row_end) { const f32x4* rp_ = (const f32x4*)(tab + (size_t)rr_ * 2048 + 4 * lane);        \
        _Pragma("unroll") for (int j = 0; j < 8; ++j) rg[slot_][j] = __builtin_nontemporal_load(rp_ + 64 * j);     } } while (0)
#define CV_ROW(slot_, row_) do { const int rr_ = (row_); float am = 0.f; \
        _Pragma("unroll") for (int j = 0; j < 8; ++j) am = fmaxf(am, fmaxf(fmaxf(fabsf(rg[slot_][j].x), fabsf(rg[slot_][j].y)), fmaxf(fabsf(rg[slot_][j].z), fabsf(rg[slot_][j].w)))); \
        am = wave_max_dpp(am); const float sc = am > 0.f ? 6.f / am : 0.f; \
        if (lane == 0) inv_scale[rr_] = am > 0.f ? am / 6.f : 0.f; \
        v4u o; \
        _Pragma("unroll") for (int d = 0; d < 4; ++d) { unsigned w = 0u; \
            w = __builtin_amdgcn_cvt_scalef32_pk_fp4_f32(w, rg[slot_][2 * d].x * sc, rg[slot_][2 * d].y * sc, 1.0f, 0); w = __builtin_amdgcn_cvt_scalef32_pk_fp4_f32(w, rg[slot_][2 * d].z * sc, rg[slot_][2 * d].w * sc, 1.0f, 1); \
            w = __builtin_amdgcn_cvt_scalef32_pk_fp4_f32(w, rg[slot_][2 * d + 1].x * sc, rg[slot_][2 * d + 1].y * sc, 1.0f, 2); w = __builtin_amdgcn_cvt_scalef32_pk_fp4_f32(w, rg[slot_][2 * d + 1].z * sc, rg[slot_][2 * d + 1].w * sc, 1.0f, 3); \
            if (d == 0) o.x = w; else if (d == 1) o.y = w; else if (d == 2) o.z = w; else o.w = w; } \
        *(v4u*)(t4 + (size_t)rr_ * 2048 + 16 * lane) = o; } while (0)
    CV_LOAD(0, row0); CV_LOAD(1, row0 + NGW); CV_LOAD(2, row0 + 2 * NGW);
#pragma unroll 1
    for (int row = row0; row < row_end; row += 4 * NGW) {
        CV_LOAD(3, row + 3 * NGW); CV_ROW(0, row);
        if (row + NGW < row_end) { CV_LOAD(0, row + 4 * NGW); CV_ROW(1, row + NGW); }
        if (row + 2 * NGW < row_end) { CV_LOAD(1, row + 5 * NGW); CV_ROW(2, row + 2 * NGW); }
        if (row + 3 * NGW < row_end) { CV_LOAD(2, row + 6 * NGW); CV_ROW(3, row + 3 * NGW); }
    }
#undef CV_LOAD
#undef CV_ROW
}

namespace att {
constexpr int D = 128, PITCH = 1024, OPITCH = 2048;
constexpr int NW = 8, QBLK = 32, KVBLK = 64, QB = NW * QBLK;
constexpr int SHM_V = KVBLK * D * 2, SHM_K = KVBLK * D * 2;
constexpr int LDS_ATT_BYTES = 2 * SHM_V + 2 * SHM_K + NW * 64 * 4;
constexpr int LDS_BIAS_OFF = 69632;
constexpr float THR2 = 11.5f;
constexpr bool WSKIP = false;

typedef short bf16x8 __attribute__((ext_vector_type(8)));
typedef short s16x4 __attribute__((ext_vector_type(4)));
typedef float f32x16 __attribute__((ext_vector_type(16)));
typedef float f32x4 __attribute__((ext_vector_type(4)));
typedef unsigned u32x4 __attribute__((ext_vector_type(4)));
template <class A, class Bt> struct same_t { static constexpr bool v = false; };
template <class A> struct same_t<A, A> { static constexpr bool v = true; };

#define KSWZ(row, colB) ((row) * 256 + ((colB) ^ (((row) & 7) << 4)))
#define SBAR() __builtin_amdgcn_sched_barrier(0)
__device__ __forceinline__ int v_st(int k, int c) { const int kk = (k & ~0xC) | ((k & 4) << 1) | ((k & 8) >> 1); return ((kk >> 3) * 4 + (c >> 5)) * 512 + ((kk & 7) * 32 + (c & 31)) * 2; }
__device__ __forceinline__ int v_rd_base(int lane) { return ((lane & 3) << 3) | (((lane >> 2) & 3) << 6) | (((lane >> 4) & 1) << 5) | (((lane >> 5) & 1) << 8); }
constexpr int v_rd_off(int d0, int ks, int half) { return d0 * 512 + ks * 4096 + half * 2048; }
__device__ __forceinline__ int crow(int r, int hi) { return (r & 3) + 8 * (r >> 2) + 4 * hi; }
__device__ __forceinline__ unsigned cvtpk(float lo, float hi) {
    unsigned r; asm volatile("v_cvt_pk_bf16_f32 %0, %1, %2" : "=v"(r) : "v"(lo), "v"(hi)); return r;
}
__device__ __forceinline__ bf16x8 pack8(f32x4 a, f32x4 b) {
    u32x4 w = {cvtpk(a[0], a[1]), cvtpk(a[2], a[3]), cvtpk(b[0], b[1]), cvtpk(b[2], b[3])};
    return *reinterpret_cast<bf16x8*>(&w);
}
template <class T> __device__ __forceinline__ bf16x8 load8(const T* p) {
    if constexpr (same_t<T, float>::v) { return pack8(*(const f32x4*)p, *(const f32x4*)(p + 4)); }
    else { return *reinterpret_cast<const bf16x8*>(p); }
}
__device__ __forceinline__ void mask_tile(f32x16& p0, f32x16& p1, int dq, unsigned W) {
    const float NEG = -__builtin_inff();
#pragma unroll
    for (int r = 0; r < 16; ++r) {
        const int c = (r & 3) + 8 * (r >> 2);
        if ((unsigned)(dq - c) >= W) p0[r] = NEG;
        if ((unsigned)(dq - c - 32) >= W) p1[r] = NEG;
    }
}
__device__ __forceinline__ void partialSM(f32x16& p0, f32x16& p1, float& m_reg, float& mn, float& alpha) {
    float pmax = p0[0]; for (int r = 1; r < 16; ++r) pmax = fmaxf(pmax, p0[r]); for (int r = 0; r < 16; ++r) pmax = fmaxf(pmax, p1[r]);
    { auto rr = __builtin_amdgcn_permlane32_swap(__float_as_uint(pmax), __float_as_uint(pmax), false, false);
      pmax = fmaxf(__uint_as_float(rr[0]), __uint_as_float(rr[1])); }
    if (__builtin_expect(__all((pmax - m_reg) <= THR2), 1)) { mn = m_reg; alpha = 1.f; }
    else { mn = fmaxf(m_reg, pmax); alpha = __builtin_amdgcn_exp2f(m_reg - mn); m_reg = mn; }
    for (int r = 0; r < 16; ++r) p0[r] = p0[r] - mn; for (int r = 0; r < 16; ++r) p1[r] = p1[r] - mn;
    for (int r = 0; r < 16; ++r) p0[r] = __builtin_amdgcn_exp2f(p0[r]);
}
__device__ __forceinline__ void finishSM(f32x16& p0, f32x16& p1, float alpha, float& l_reg, bf16x8& pa0, bf16x8& pa1, bf16x8& pa2, bf16x8& pa3) {
    for (int r = 0; r < 16; ++r) p1[r] = __builtin_amdgcn_exp2f(p1[r]);
    float ps = 0; for (int r = 0; r < 16; ++r) ps += p0[r]; for (int r = 0; r < 16; ++r) ps += p1[r];
    { auto rr = __builtin_amdgcn_permlane32_swap(__float_as_uint(ps), __float_as_uint(ps), false, false);
      ps = __uint_as_float(rr[0]) + __uint_as_float(rr[1]); }
    l_reg = l_reg * alpha + ps;
#define PK4(P, B_, OUT) do { unsigned a0 = cvtpk(P[B_+0], P[B_+1]), a1 = cvtpk(P[B_+2], P[B_+3]);                          \
        unsigned b0 = cvtpk(P[B_+4], P[B_+5]), b1 = cvtpk(P[B_+6], P[B_+7]);                                             \
        auto r0 = __builtin_amdgcn_permlane32_swap(a0, b0, false, false); auto r1 = __builtin_amdgcn_permlane32_swap(a1, b1, false, false); \
        u32x4 w = {r0[0], r1[0], r0[1], r1[1]}; OUT = *reinterpret_cast<bf16x8*>(&w); } while (0)
    PK4(p0, 0, pa0); PK4(p0, 8, pa1); PK4(p1, 0, pa2); PK4(p1, 8, pa3);
#undef PK4
}
template <int KB, bool SK>
__device__ __forceinline__ void qkt(f32x16& p0, f32x16& p1, const char* K_lds, int r32, int hi, const bf16x8* qr, bool act) {
    if (SK && !act) { const float NEG = -__builtin_inff();
#pragma unroll
        for (int r = 0; r < 16; ++r) { p0[r] = NEG; p1[r] = NEG; } return; }
    p0 = f32x16{}; p1 = f32x16{};
    const char* kb[4];
#pragma unroll
    for (int dd = 0; dd < 4; ++dd) kb[dd] = K_lds + KB * SHM_K + KSWZ(r32, (dd * 16 + hi * 8) * 2);
#pragma unroll
    for (int d0 = 0; d0 < 8; ++d0) { const char* a = kb[d0 & 3] + (d0 >> 2) * 128;
        bf16x8 b0 = *reinterpret_cast<const bf16x8*>(a);
        bf16x8 b1 = *reinterpret_cast<const bf16x8*>(a + 32 * 256);
        p0 = __builtin_amdgcn_mfma_f32_32x32x16_bf16(b0, qr[d0], p0, 0, 0, 0);
        p1 = __builtin_amdgcn_mfma_f32_32x32x16_bf16(b1, qr[d0], p1, 0, 0, 0); }
}
template <int VB, bool SK>
__device__ __forceinline__ void pv_tile(f32x16* o, int vb0, bf16x8 pa0, bf16x8 pa1, bf16x8 pa2, bf16x8 pa3, bool act) {
    if (SK && !act) return;
#define TRRD(dst, off) asm volatile("ds_read_b64_tr_b16 %0, %1 offset:%2" : "=&v"(dst) : "v"(vb0), "i"(off) : "memory")
#define PV_D0(d0) do { s16x4 l0, l1, l2, l3, h0, h1, h2, h3; constexpr int b_ = VB * SHM_V + v_rd_off(d0, 0, 0);     \
        TRRD(l0, b_); TRRD(h0, b_ + 2048); TRRD(l1, b_ + 4096); TRRD(h1, b_ + 6144); TRRD(l2, b_ + 8192); TRRD(h2, b_ + 10240); TRRD(l3, b_ + 12288); TRRD(h3, b_ + 14336); \
        asm volatile("s_waitcnt lgkmcnt(0)" ::: "memory"); SBAR();                 \
        o[d0] = __builtin_amdgcn_mfma_f32_32x32x16_bf16(pa0, (bf16x8){l0[0], l0[1], l0[2], l0[3], h0[0], h0[1], h0[2], h0[3]}, o[d0], 0, 0, 0);   \
        o[d0] = __builtin_amdgcn_mfma_f32_32x32x16_bf16(pa1, (bf16x8){l1[0], l1[1], l1[2], l1[3], h1[0], h1[1], h1[2], h1[3]}, o[d0], 0, 0, 0);   \
        o[d0] = __builtin_amdgcn_mfma_f32_32x32x16_bf16(pa2, (bf16x8){l2[0], l2[1], l2[2], l2[3], h2[0], h2[1], h2[2], h2[3]}, o[d0], 0, 0, 0);   \
        o[d0] = __builtin_amdgcn_mfma_f32_32x32x16_bf16(pa3, (bf16x8){l3[0], l3[1], l3[2], l3[3], h3[0], h3[1], h3[2], h3[3]}, o[d0], 0, 0, 0); } while (0)
    PV_D0(0); PV_D0(1); PV_D0(2); PV_D0(3);
#undef PV_D0
#undef TRRD
}

typedef unsigned u32x2 __attribute__((ext_vector_type(2)));
__device__ __forceinline__ void sel_tile(f32x16& p0, f32x16& p1, u32x2 mw, int hi) {
    const unsigned w0 = mw.x >> (4 * hi), w1 = mw.y >> (4 * hi);
#pragma unroll
    for (int r = 0; r < 16; ++r) {
        const int c = (r & 3) + 8 * (r >> 2);
        const unsigned m0 = (unsigned)__builtin_amdgcn_sbfe((int)w0, c, 1), m1 = (unsigned)__builtin_amdgcn_sbfe((int)w1, c, 1);
        const float x0 = p0[r], x1 = p1[r];
        p0[r] = __uint_as_float((__float_as_uint(x0) & m0) | (0xFF800000u & ~m0));
        p1[r] = __uint_as_float((__float_as_uint(x1) & m1) | (0xFF800000u & ~m1));
    }
}
__device__ __forceinline__ void bias_tile(f32x16& p0, f32x16& p1, int dq, const float* btab) {
#pragma unroll
    for (int r = 0; r < 16; ++r) {
        const int c = (r & 3) + 8 * (r >> 2);
        const unsigned i0 = (unsigned)(dq - c), i1 = (unsigned)(dq - c - 32);
        p0[r] += btab[i0 < 128u ? i0 : 128u]; p1[r] += btab[i1 < 128u ? i1 : 128u];
    }
}
template <class TIn, class TOut> struct BlockRef { const TIn* Q; const TIn* K; const TIn* V; TOut* O; int P0; const unsigned* MR; int head; };
template <class TIn> struct Seam {
    bf16x8 qr[8];
    bf16x8 st_v0, st_v1, st_k0, st_k1; f32x4 sf0, sf1, sf2, sf3;
    f32x4 tq[16];
};
__device__ __forceinline__ int swa_jlo(int P0, int W) { const int lowk = P0 - W + 1; return lowk > 0 ? lowk / KVBLK : 0; }
#define ROW(p, k0, rr) ((p) + (size_t)((k0) + (rr)) * PITCH + sc)
#define VMW() asm volatile("s_waitcnt vmcnt(0)" ::: "memory")
#define VMWN(n) asm volatile("s_waitcnt vmcnt(%0)" :: "i"(n) : "memory")
#define ROWB(p, k0, ro) ((const TIn*)(((const char*)((p) + (size_t)(k0) * PITCH)) + (ro)))
#define SLOAD_H(Kp, Vp, k0) do { S.st_v0 = load8<TIn>(ROWB(Vp, k0, roff0)); S.st_v1 = load8<TIn>(ROWB(Vp, k0, roff1));              \
                         S.st_k0 = load8<TIn>(ROWB(Kp, k0, roff0)); S.st_k1 = load8<TIn>(ROWB(Kp, k0, roff1)); } while (0)
#define SWRITE_HK(bf) do { *(bf16x8*)(K_lds + (bf) * SHM_K + kws) = S.st_k0; *(bf16x8*)(K_lds + (bf) * SHM_K + kws + 32 * 256) = S.st_k1; } while (0)
#define SWRITE_HV(bf) do { *(bf16x8*)(V_lds + (bf) * SHM_V + vst0) = S.st_v0; *(bf16x8*)(V_lds + (bf) * SHM_V + vst1) = S.st_v1; } while (0)
#define SWRITE_H(bf) do { SWRITE_HV(bf); SWRITE_HK(bf); } while (0)
#define SLOAD_F(p, k0) do { S.sf0 = *(const f32x4*)ROW(p, k0, sr); S.sf1 = *(const f32x4*)(ROW(p, k0, sr) + 4);                \
                            S.sf2 = *(const f32x4*)ROW(p, k0, 32 + sr); S.sf3 = *(const f32x4*)(ROW(p, k0, 32 + sr) + 4); } while (0)
#define SWRITE_KF(bf) do { *(bf16x8*)(K_lds + (bf) * SHM_K + kws) = pack8(S.sf0, S.sf1); *(bf16x8*)(K_lds + (bf) * SHM_K + kws + 32 * 256) = pack8(S.sf2, S.sf3); } while (0)
#define SWRITE_VF(bf) do { *(bf16x8*)(V_lds + (bf) * SHM_V + vst0) = pack8(S.sf0, S.sf1); *(bf16x8*)(V_lds + (bf) * SHM_V + vst1) = pack8(S.sf2, S.sf3); } while (0)
template <class TIn, class TOut>
__device__ __forceinline__ void causal_swa_prime(const BlockRef<TIn, TOut>& cur, int W, char* lds, Seam<TIn>& S, const int tid_in) {
    constexpr bool F32 = same_t<TIn, float>::v;
    const int tid = tid_in, wid = __builtin_amdgcn_readfirstlane(tid >> 6), lane = tid & 63, r32 = lane & 31, hi = lane >> 5;
    const int sr = tid >> 4, sc = (tid & 15) * 8, kws = KSWZ(sr, sc * 2); char* K_lds = lds + 2 * SHM_V;
    const unsigned roff0 = (unsigned)(sr * PITCH + sc) * 2u, roff1 = roff0 + 32u * PITCH * 2u;
    const int kb0 = swa_jlo(cur.P0, W) * KVBLK;
    { const char* qb_ = (const char*)(cur.Q + (size_t)(wid * QBLK) * PITCH); const unsigned qo_ = (unsigned)(r32 * PITCH + hi * 8) * 2u;
      for (int d0 = 0; d0 < 8; ++d0) S.qr[d0] = *(const bf16x8*)((qb_ + qo_) + d0 * 32); }
    if constexpr (F32) { SLOAD_F((const float*)cur.K, kb0); VMW(); SWRITE_KF(0); SBAR(); SLOAD_F((const float*)cur.V, kb0); }
    else { SLOAD_H(cur.K, cur.V, kb0); VMW(); SWRITE_HK(0); }
    __syncthreads();
}
template <class TIn, class TOut>
__device__ __forceinline__ void causal_swa_block(const BlockRef<TIn, TOut>& cur, const BlockRef<TIn, TOut>& nxt, int skv, int W, char* lds, Seam<TIn>& S, const int tid_in) {
    constexpr bool F32 = same_t<TIn, float>::v;
    const int tid = tid_in, wid = __builtin_amdgcn_readfirstlane(tid >> 6), lane = tid & 63, r32 = lane & 31, hi = lane >> 5;
    const int j_lo = swa_jlo(cur.P0, W);
    int j_hi = (cur.P0 + QB - 1) / KVBLK + 1; if (j_hi > skv / KVBLK) j_hi = skv / KVBLK;
    const int NT = j_hi - j_lo;
    const int kbn = swa_jlo(nxt.P0, W) * KVBLK;
    const int qlo = cur.P0 + wid * QBLK, qm = qlo + r32 - 4 * hi;
    char* V_lds = lds; char* K_lds = lds + 2 * SHM_V;
    float* ws = (float*)(lds + 2 * SHM_V + 2 * SHM_K) + wid * 64; float* li_l = ws, * al_l = ws + 32;
    float m_reg = -1e30f, l_reg = 0; f32x16 o[4] = {};
    const int sr = tid >> 4, sc = (tid & 15) * 8, vst0 = v_st(sr, sc), vst1 = v_st(32 + sr, sc), kws = KSWZ(sr, sc * 2);
    const unsigned roff0 = (unsigned)(sr * PITCH + sc) * 2u, roff1 = roff0 + 32u * PITCH * 2u;
    const int vb0 = (int)(uintptr_t)V_lds + v_rd_base(lane);
    const TIn* Kh = cur.K; const TIn* Vh = cur.V;
    const unsigned mrow_off = (unsigned)(wid * QBLK + r32) * 512u; u32x2 mw = (u32x2){0u, 0u};
    const float* btab = (const float*)(lds + LDS_BIAS_OFF) + cur.head * 132;
#define RESC(a) do { if (__any((a) < 1.f)) { if (hi == 0) al_l[r32] = (a); asm volatile("s_waitcnt lgkmcnt(0)" ::: "memory");              \
                     for (int d_ = 0; d_ < 4; ++d_) for (int r = 0; r < 16; ++r) o[d_][r] *= al_l[crow(r, hi)]; } } while (0)
#define KBASE(t) ((j_lo + (t)) * KVBLK)
#define ACT(t) (KBASE(t) <= qlo + QBLK - 1 && KBASE(t) + KVBLK - 1 >= qlo - W + 1)
#define MASKT(P0_, P1_, t) do { const int kb_ = KBASE(t); if (kb_ <= qlo + QBLK - 1 && kb_ + KVBLK - 1 >= qlo - 127) bias_tile(P0_, P1_, qm - kb_, btab); sel_tile(P0_, P1_, mw, hi); } while (0)
#define MWLOAD(t) do { const char* mb_ = (const char*)cur.MR + 8 * (j_lo + (t)); mw = *(const u32x2*)(mb_ + mrow_off); } while (0)
    constexpr int NQL = F32 ? 16 : 8;
    constexpr bool SK = WSKIP && !F32;
#define SEAM_K0() do { VMWN(NQL); if constexpr (F32) { SWRITE_KF(0); SBAR(); SLOAD_F((const float*)nxt.V, kbn); } else { SWRITE_HK(0); } SBAR(); } while (0)
    f32x16 pA0, pA1, pB0, pB1; float mnA, mnB, alA, alB; bf16x8 pa0, pa1, pa2, pa3;
    if constexpr (F32) { VMW(); SWRITE_VF(0); SBAR(); } else { SWRITE_HV(0); SBAR(); }
    if (NT > 1) { if constexpr (F32) SLOAD_F((const float*)Kh, KBASE(1)); else SLOAD_H(Kh, Vh, KBASE(1)); }
    MWLOAD(0); SBAR(); qkt<0, SK>(pA0, pA1, K_lds, r32, hi, S.qr, ACT(0));
    if constexpr (F32) { if (NT > 1) { VMW(); SWRITE_KF(1); SBAR(); SLOAD_F((const float*)Vh, KBASE(1)); } }
    MASKT(pA0, pA1, 0); partialSM(pA0, pA1, m_reg, mnA, alA);
    if (NT > 1) { VMW(); if constexpr (F32) { SWRITE_VF(1); SBAR(); if (NT > 2) SLOAD_F((const float*)Kh, KBASE(2)); } else SWRITE_H(1); }
    __syncthreads();
#define HALF_STEP(PX0, PX1, mnX, alX, PY0, PY1, alY, t, KB, VB, SB) do {                                                      \
        MWLOAD(t); SBAR(); qkt<KB, SK>(PX0, PX1, K_lds, r32, hi, S.qr, ACT(t));                                             \
        finishSM(PY0, PY1, alY, l_reg, pa0, pa1, pa2, pa3); SBAR();                                                           \
        if ((t) + 1 < NT) { if constexpr (F32) { VMW(); SWRITE_KF(SB); SBAR(); SLOAD_F((const float*)Vh, KBASE((t) + 1)); }  \
                            else { SLOAD_H(Kh, Vh, KBASE((t) + 1)); } SBAR(); }                                               \
        pv_tile<VB, SK>(o, vb0, pa0, pa1, pa2, pa3, ACT((t) - 1)); MASKT(PX0, PX1, (t)); partialSM(PX0, PX1, m_reg, mnX, alX);                                        \
        __syncthreads();                                                                                                      \
        if ((t) + 1 < NT) { VMW(); if constexpr (F32) { SWRITE_VF(SB); SBAR(); if ((t) + 2 < NT) SLOAD_F((const float*)Kh, KBASE((t) + 2)); } \
                            else { SWRITE_H(SB); } }                                                                          \
        RESC(alX); __syncthreads(); } while (0)
    for (int t = 1; t + 1 < NT; t += 2) {
        HALF_STEP(pB0, pB1, mnB, alB, pA0, pA1, alA, t, 1, 0, 0);
        HALF_STEP(pA0, pA1, mnA, alA, pB0, pB1, alB, t + 1, 0, 1, 1);
    }
    const bool even = (NT & 1) == 0;
    if (even) { MWLOAD(NT - 1); SBAR(); qkt<1, SK>(pB0, pB1, K_lds, r32, hi, S.qr, ACT(NT - 1)); SBAR(); }
#define QROW(e) (nxt.Q + (size_t)(wid * QBLK + r32) * PITCH + ((e) >> 1) * 16 + hi * 8 + ((e) & 1) * 4)
    if constexpr (F32) { SLOAD_F((const float*)nxt.K, kbn); SBAR();
#pragma unroll
        for (int e = 0; e < 8; ++e) S.tq[e] = *(const f32x4*)QROW(e); }
    else { SLOAD_H(nxt.K, nxt.V, kbn); SBAR();
        { const char* qb_ = (const char*)(nxt.Q + (size_t)(wid * QBLK) * PITCH); const unsigned qo_ = (unsigned)(r32 * PITCH + hi * 8) * 2u;
_Pragma("unroll")
          for (int d0 = 0; d0 < 8; ++d0) S.qr[d0] = *(const bf16x8*)((qb_ + qo_) + d0 * 32); } }
    SBAR();
    finishSM(pA0, pA1, alA, l_reg, pa0, pa1, pa2, pa3); SBAR();
    if constexpr (F32) {
#pragma unroll
        for (int e = 8; e < 16; ++e) S.tq[e] = *(const f32x4*)QROW(e); SBAR(); }
#undef QROW
    pv_tile<0, SK>(o, vb0, pa0, pa1, pa2, pa3, ACT(even ? NT - 2 : NT - 1));
    if (even) { MASKT(pB0, pB1, NT - 1); partialSM(pB0, pB1, m_reg, mnB, alB); __syncthreads(); RESC(alB);
        finishSM(pB0, pB1, alB, l_reg, pa0, pa1, pa2, pa3); SBAR(); pv_tile<1, SK>(o, vb0, pa0, pa1, pa2, pa3, ACT(NT - 1)); }
    SBAR(); SEAM_K0();
    if (hi == 0) li_l[r32] = l_reg; asm volatile("s_waitcnt lgkmcnt(0)" ::: "memory");
    float rli[16];
#pragma unroll
    for (int r = 0; r < 16; ++r) rli[r] = __builtin_amdgcn_rcpf(li_l[crow(r, hi)]);
    char* Ow = (char*)(cur.O + (size_t)(wid * QBLK) * OPITCH); const unsigned oo_ = (unsigned)(4 * hi * OPITCH + r32) * 2u;
#pragma unroll
    for (int r = 0; r < 16; ++r) { const int orow0 = (r & 3) + 8 * (r >> 2);
#pragma unroll
        for (int d0 = 0; d0 < 4; ++d0) { const float v = o[d0][r] * rli[r];
            if constexpr (same_t<TOut, float>::v) { }
            else { const float vn = __shfl_xor(v, 1);
                   if ((r32 & 1) == 0) *(unsigned*)((Ow + oo_) + (orow0 * OPITCH + d0 * 32) * 2) = cvtpk(v, vn); } } }
    if constexpr (F32) {
#pragma unroll
        for (int d0 = 0; d0 < 8; ++d0) S.qr[d0] = pack8(S.tq[2 * d0], S.tq[2 * d0 + 1]); }
    __syncthreads();
#undef RESC
#undef KBASE
#undef ACT
#undef MASKT
#undef MWLOAD
#undef SEAM_K0
#undef HALF_STEP
}
#undef ROW
#undef VMW
#undef VMWN
#undef SLOAD_H
#undef ROWB
#undef SWRITE_HK
#undef SWRITE_HV
#undef SWRITE_H
#undef SLOAD_F
#undef SWRITE_KF
#undef SWRITE_VF
}

__device__ __forceinline__ att::BlockRef<bf16, bf16> attn_ref(int bh, int qb, const bf16* Q, const bf16* K, const bf16* V, const unsigned* mask, bf16* mixin) {
    const int b = bh >> 3, h = bh & 7; att::BlockRef<bf16, bf16> r;
    const size_t row0 = (size_t)b * SEQ + (size_t)qb * att::QB;
    r.Q = Q + row0 * 1024 + h * 128; r.K = K + (size_t)b * SEQ * 1024 + h * 128; r.V = V + (size_t)b * SEQ * 1024 + h * 128;
    r.O = mixin + row0 * 2048 + 1024 + h * 128; r.P0 = qb * att::QB; r.MR = mask + row0 * 128; r.head = h;
    return r;
}
__device__ __forceinline__ void phase_attn_fast(const Frame& F, const bf16* Q, const bf16* K, const bf16* V, const unsigned* mask, const float* rel_bias, bf16* mixin) {
    char* lds = (char*)F.ldsg;
    float* bt = (float*)(lds + att::LDS_BIAS_OFF);
    for (int i = F.tid; i < 8 * 132; i += NTHREADS) { const int h = i / 132, d = i - h * 132;
        bt[i] = (d < 128) ? (rel_bias[t5_bucket(d) * 8 + h] - rel_bias[31 * 8 + h]) * LOG2E : 0.f; }
    __syncthreads();
    constexpr int W = 1 << 20, NITEM = 256;
    int L = F.vcu; if (L >= NITEM) return;
    int pass = 0;
    att::BlockRef<bf16, bf16> cur = attn_ref(L >> 3, L & 7, Q, K, V, mask, mixin);
    att::Seam<bf16> S;
    att::causal_swa_prime<bf16, bf16>(cur, W, lds, S, F.tid);
    for (;;) {
        const bool more_pass = pass == 0, more_item = L + F.G < NITEM, last = !more_pass && !more_item;
        int passn = pass + 1, Ln = L;
        if (!more_pass) { passn = 0; Ln = more_item ? L + F.G : L; }
        const att::BlockRef<bf16, bf16> nxt = last ? cur : attn_ref(Ln >> 3, passn ? 15 - (Ln & 7) : (Ln & 7), Q, K, V, mask, mixin);
        att::causal_swa_block<bf16, bf16>(cur, nxt, SEQ, W, lds, S, F.tid);
        if (last) break;
        cur = nxt; pass = passn; L = Ln;
    }
}

typedef __bf16 bf16x2_t __attribute__((ext_vector_type(2)));
__device__ __forceinline__ unsigned cvtpk_relu(float lo, float hi) { const int li = __float_as_int(lo), hi_i = __float_as_int(hi);
    const f32x2 v = {__int_as_float(li > 0 ? li : 0), __int_as_float(hi_i > 0 ? hi_i : 0)}; const bf16x2_t b = __builtin_convertvector(v, bf16x2_t); return __builtin_bit_cast(unsigned, b); }
__device__ __forceinline__ int half_sum_i(int v, int hi) {
    v += __builtin_amdgcn_update_dpp(0, v, 0xB1, 0xf, 0xf, true);
    v += __builtin_amdgcn_update_dpp(0, v, 0x4E, 0xf, 0xf, true);
    v += __builtin_amdgcn_update_dpp(0, v, 0x141, 0xf, 0xf, true);
    v += __builtin_amdgcn_update_dpp(0, v, 0x140, 0xf, 0xf, true);
    v += __builtin_amdgcn_update_dpp(0, v, 0x142, 0xa, 0xf, false);
    const int t0 = __builtin_amdgcn_readlane(v, 31), t1 = __builtin_amdgcn_readlane(v, 63);
    return hi ? t1 : t0;
}
__device__ __forceinline__ unsigned half_max_u(unsigned v, int hi) {
    unsigned t;
    t = (unsigned)__builtin_amdgcn_update_dpp(0, (int)v, 0xB1, 0xf, 0xf, true); v = t > v ? t : v;
    t = (unsigned)__builtin_amdgcn_update_dpp(0, (int)v, 0x4E, 0xf, 0xf, true); v = t > v ? t : v;
    t = (unsigned)__builtin_amdgcn_update_dpp(0, (int)v, 0x141, 0xf, 0xf, true); v = t > v ? t : v;
    t = (unsigned)__builtin_amdgcn_update_dpp(0, (int)v, 0x140, 0xf, 0xf, true); v = t > v ? t : v;
    t = (unsigned)__builtin_amdgcn_update_dpp(0, (int)v, 0x142, 0xa, 0xf, false); v = t > v ? t : v;
    const unsigned t0 = (unsigned)__builtin_amdgcn_readlane((int)v, 31), t1 = (unsigned)__builtin_amdgcn_readlane((int)v, 63);
    return hi ? t1 : t0;
}
constexpr int LN1_L_STATS = 132096;
constexpr int IDX_L_LIST = 148480;
constexpr int IDX_L_W2 = 132096;
__device__ __forceinline__ void indexer_unit(const Frame& F, int b, int u, const bf16* qi, const bf16* kiwi, unsigned* mask) {
    const int lane = F.lane, c = lane & 31, hi = lane >> 5, w = F.wave;
    const int b0 = b * SEQ, t0 = u * 16, tq = t0 + 2 * w + hi;
    const int nchunk = (t0 + 16 + 255) >> 8;
    LAS unsigned char* ring = F.lds;
    bf16x8 af[4];
    { const bf16* ap = qi + (size_t)(b0 + t0 + 2 * w + ((c >> 2) & 1)) * 1024 + ((c & 3) + 4 * (c >> 3)) * 64 + 8 * hi;
#pragma unroll
      for (int ks = 0; ks < 4; ++ks) af[ks] = *(const bf16x8*)(ap + 16 * ks); }
    f32x2 wv2[8];
    { const bf16* wp = kiwi + (size_t)(b0 + t0 + 2 * w + hi) * 256 + 64;
      const u32x4 wa = *(const u32x4*)wp, wb = *(const u32x4*)(wp + 8);
      wv2[0] = (f32x2){bflo(wa.x), bfhi(wa.x)}; wv2[1] = (f32x2){bflo(wa.y), bfhi(wa.y)}; wv2[2] = (f32x2){bflo(wa.z), bfhi(wa.z)}; wv2[3] = (f32x2){bflo(wa.w), bfhi(wa.w)};
      wv2[4] = (f32x2){bflo(wb.x), bfhi(wb.x)}; wv2[5] = (f32x2){bflo(wb.y), bfhi(wb.y)}; wv2[6] = (f32x2){bflo(wb.z), bfhi(wb.z)}; wv2[7] = (f32x2){bflo(wb.w), bfhi(wb.w)}; }
    const char* kbase = (const char*)(kiwi + (size_t)b0 * 256);
#define IDX_ISSUE(ck) do { const int ckc_ = (ck) < nchunk ? (ck) : nchunk - 1; const char* g_ = kbase + (size_t)ckc_ * (256 * 512); \
        _Pragma("unroll") for (int i_ = 0; i_ < 4; ++i_) { const int p_ = (4 * w + i_) * 64 + lane, row_ = p_ >> 3; const unsigned so_ = (unsigned)(row_ * 512 + (((p_ & 7) ^ ((row_ >> 1) & 7)) << 4)); __builtin_amdgcn_global_load_lds((const unsigned*)(g_ + so_), (LAS unsigned*)(ring + ((ck) & 3) * 32768 + (4 * w + i_) * 1024), 16, 0, 0); } } while (0)
    const unsigned bbase = (unsigned)(c * 128 + ((hi ^ ((c >> 1) & 7)) << 4));
    unsigned sc[128];
    IDX_ISSUE(0); IDX_ISSUE(1); IDX_ISSUE(2);
#pragma unroll
    for (int ck = 0; ck < 16; ++ck) {
        if (ck < nchunk) {
            asm volatile("s_waitcnt vmcnt(8)" ::: "memory"); __builtin_amdgcn_s_barrier(); asm volatile("" ::: "memory");
            IDX_ISSUE(ck + 3);
            unsigned cbv[4];
#pragma unroll
            for (int ks = 0; ks < 4; ++ks) { cbv[ks] = (bbase ^ (unsigned)(ks << 5)) + (unsigned)((ck & 3) * 32768); asm volatile("" : "+v"(cbv[ks])); }
            bf16x8 bq[4]; unsigned la[4]; f32x16 ac[2];
#define IDX_BREAD(t_) do { _Pragma("unroll") for (int ks = 0; ks < 4; ++ks) asm volatile("ds_read_b128 %0, %1 offset:%2" : "=v"(bq[ks]) : "v"(la[ks]), "n"((t_) * 4096)); } while (0)
#define IDX_BWAIT() asm volatile("s_waitcnt lgkmcnt(0)" : "+v"(bq[0]), "+v"(bq[1]), "+v"(bq[2]), "+v"(bq[3]))
#define IDX_MM(t_) do { f32x16 a_ = (f32x16){0.f, 0.f, 0.f, 0.f, 0.f, 0.f, 0.f, 0.f, 0.f, 0.f, 0.f, 0.f, 0.f, 0.f, 0.f, 0.f}; \
        _Pragma("unroll") for (int ks = 0; ks < 4; ++ks) a_ = __builtin_amdgcn_mfma_f32_32x32x16_bf16(af[ks], bq[ks], a_, 0, 0, 0); ac[(t_) & 1] = a_; } while (0)
#pragma unroll
            for (int ks = 0; ks < 4; ++ks) la[ks] = (unsigned)(size_t)(ring + cbv[ks]);
            IDX_BREAD(0); IDX_BWAIT(); IDX_MM(0);
            __builtin_amdgcn_sched_barrier(0);
            IDX_BREAD(1);
            __builtin_amdgcn_sched_barrier(0);
#pragma unroll
            for (int tt = 0; tt < 8; ++tt) {
                if (tt < 7) { IDX_BWAIT(); IDX_MM(tt + 1); }
                __builtin_amdgcn_sched_barrier(0);
                if (tt < 6) { IDX_BREAD(tt + 2); __builtin_amdgcn_sched_barrier(0); }
                const f32x16 acc = ac[tt & 1];
                f32x2 sm0 = (f32x2){0.f, 0.f}, sm1 = (f32x2){0.f, 0.f};
#pragma unroll
                for (int r = 0; r < 8; ++r) { const int a0 = __float_as_int(acc[2 * r]), a1 = __float_as_int(acc[2 * r + 1]);
                    const f32x2 av = (f32x2){__int_as_float(a0 > 0 ? a0 : 0), __int_as_float(a1 > 0 ? a1 : 0)};
                    if (r & 1) sm1 = av * wv2[r] + sm1; else sm0 = av * wv2[r] + sm0; }
                const f32x2 sm = sm0 + sm1;
                const float y0 = sm.x + sm.y;
                if (ck * 256 + 255 <= t0) sc[ck * 8 + tt] = sortable(y0);
                else { const int key = ck * 256 + tt * 32 + c; sc[ck * 8 + tt] = (key <= tq) ? sortable(y0) : 0u; }
                __builtin_amdgcn_sched_barrier(0);
            }
#undef IDX_BREAD
#undef IDX_BWAIT
#undef IDX_MM
        } else {
#pragma unroll
            for (int tt = 0; tt < 8; ++tt) sc[ck * 8 + tt] = 0u;
        }
    }
#undef IDX_ISSUE
    asm volatile("s_waitcnt vmcnt(0)" ::: "memory"); __builtin_amdgcn_s_barrier(); asm volatile("" ::: "memory");
    constexpr int MCAP = 64;
    unsigned kmx = 0u, kmn = 0xFFFFFFFFu;
#pragma unroll
    for (int ck = 0; ck < 16; ++ck) if (ck < nchunk) {
#pragma unroll
        for (int tt = 0; tt < 8; ++tt) kmx = sc[ck * 8 + tt] > kmx ? sc[ck * 8 + tt] : kmx; }
#pragma unroll
    for (int tt = 0; tt < 8; ++tt) kmn = sc[tt] < kmn ? sc[tt] : kmn;
    kmx = half_max_u(kmx, hi); kmn = ~half_max_u(~kmn, hi);
    const bool allsel = (tq + 1 <= TOPK);
    unsigned lo = allsel ? 0u : kmn, hk = allsel ? 0u : kmx + 1u;
    int clo = allsel ? 0 : tq + 1, chi = 0, side = -1;
    float glo = (float)clo - 255.5f, ghi = -255.5f;
    bool act = (clo - chi > MCAP) && (hk - lo > 1u);
#pragma unroll 1
    for (int it = 0; it < 160; ++it) {
        if (!__any(act)) break;
        float f = glo * __builtin_amdgcn_rcpf(glo - ghi);
        if (it >= 12 && (it & 1)) f = 0.5f;
        const float vlo = unsortable(lo), vhi = unsortable(hk);
        unsigned cand = sortable(vlo + (vhi - vlo) * f);
        if (it >= 48) cand = lo + ((hk - lo) >> 1);
        cand = cand <= lo ? lo + 1u : cand; cand = cand >= hk ? hk - 1u : cand;
        int cnt = 0;
#pragma unroll
        for (int ck = 0; ck < 16; ++ck) if (ck < nchunk) {
#pragma unroll
            for (int tt = 0; tt < 8; ++tt) cnt += (sc[ck * 8 + tt] >= cand) ? 1 : 0; }
        const int tot = half_sum_i(cnt, hi);
        if (act) {
            if (tot >= TOPK) { lo = cand; clo = tot; glo = (float)tot - 255.5f; if (side == 0) ghi *= 0.5f; side = 0; }
            else             { hk = cand; chi = tot; ghi = (float)tot - 255.5f; if (side == 1) glo *= 0.5f; side = 1; }
            act = (clo - chi > MCAP) && (hk - lo > 1u);
        }
    }
    const unsigned lt = (1u << c) - 1u;
    const bool uselist = !allsel && (hk - lo > 1u);
    const unsigned wdl = uselist ? hk - lo : 0u;
    LAS unsigned* lst = (LAS unsigned*)(F.lds + IDX_L_LIST + (w * 2 + hi) * 256);
    int pos = 0;
#pragma unroll
    for (int ck = 0; ck < 16; ++ck) if (ck < nchunk) {
#pragma unroll
        for (int tt = 0; tt < 8; ++tt) { const unsigned k = sc[ck * 8 + tt];
            const bool inb = (k - lo) < wdl;
            const unsigned long long bm = __ballot(inb);
            if (bm != 0ull) { const unsigned mh = hi ? (unsigned)(bm >> 32) : (unsigned)bm;
                if (inb) lst[pos + __popc(mh & lt)] = k;
                pos += __popc(mh); } } }
    asm volatile("s_waitcnt lgkmcnt(0)" ::: "memory");
    const int mm = max(__builtin_amdgcn_readlane(pos, 0), __builtin_amdgcn_readlane(pos, 32));
    const unsigned e0 = (c < pos) ? lst[c] : 0u, e1 = (c + 32 < pos) ? lst[c + 32] : 0u;
    int r0 = 0, r1 = 0;
#pragma unroll 1
    for (int j = 0; j < mm; ++j) { unsigned x = lst[j]; x = (j < pos) ? x : 0u; r0 += (x >= e0) ? 1 : 0; r1 += (x >= e1) ? 1 : 0; }
    const int needp = TOPK - chi;
    const unsigned q0 = (r0 >= needp) ? e0 : 0u, q1 = (r1 >= needp) ? e1 : 0u;
    const unsigned taul = half_max_u(q0 > q1 ? q0 : q1, hi);
    const unsigned tau = uselist ? taul : lo;
    const int cgl = half_sum_i(((e0 > tau) ? 1 : 0) + ((e1 > tau) ? 1 : 0), hi);
    const int need = TOPK - (chi + (uselist ? cgl : 0));
    unsigned* mrow = mask + (size_t)(b0 + tq) * 128;
    const int neq = half_sum_i(((e0 == tau) ? 1 : 0) + ((e1 == tau) ? 1 : 0), hi);
    const bool simple = allsel || (uselist && neq == need);
    unsigned wv = 0u;
    if (__all(simple)) {
        const unsigned tl = tau > 1u ? tau : 1u;
#pragma unroll
        for (int T = 0; T < 128; ++T) {
            unsigned word = 0u;
            if ((T >> 3) < nchunk) { const unsigned long long bs = __ballot(sc[T] >= tl); word = hi ? (unsigned)(bs >> 32) : (unsigned)bs; }
            if (c == (T & 31)) wv = word;
            if ((T & 31) == 31) mrow[(T >> 5) * 32 + c] = wv;
        }
        return;
    }
    int run = 0;
#pragma unroll
    for (int T = 0; T < 128; ++T) {
        unsigned word = 0u;
        if ((T >> 3) < nchunk) {
            const unsigned k = sc[T];
            const bool eq = (k == tau) && (k != 0u);
            const unsigned long long bm = __ballot(eq);
            const unsigned mh = hi ? (unsigned)(bm >> 32) : (unsigned)bm;
            const bool sel = ((k > tau) && (k != 0u)) || (eq && (run + __popc(mh & lt) < need));
            run += __popc(mh);
            const unsigned long long bs = __ballot(sel);
            word = hi ? (unsigned)(bs >> 32) : (unsigned)bs;
        }
        if (c == (T & 31)) wv = word;
        if ((T & 31) == 31) mrow[(T >> 5) * 32 + c] = wv;
    }
}
__device__ __forceinline__ void phase_indexer_fast(const Frame& F, const bf16* qi, const bf16* kiwi, unsigned* mask) {
    for (int base = F.vcu; base < 256; base += F.G) {
#pragma unroll 1
        for (int i = 0; i < 4; ++i) indexer_unit(F, i, (i & 1) ? 255 - base : base, qi, kiwi, mask);
    }
}

struct Args { const float* in[14]; float* out; unsigned char* ws; };

__global__ void __launch_bounds__(NTHREADS, 2) mega_fwd(Args args) {
    extern __shared__ __attribute__((aligned(16))) unsigned char lds[];
#define FRAME_INIT() Frame F; { int l_; asm volatile("v_mbcnt_lo_u32_b32 %0, -1, 0\n\tv_mbcnt_hi_u32_b32 %0, -1, %0" : "=v"(l_)); const int t_ = wave0 * 64 + l_; F.lds = (LAS unsigned char*)lds; F.ldsg = lds; F.tid = t_; F.lane = l_; F.wave = wave0; \
        F.G = gridDim.x; const int bx_ = blockIdx.x; F.vcu = (F.G % 8 == 0) ? (bx_ % 8) * (F.G / 8) + bx_ / 8 : bx_; }
    LAS unsigned char* ldsl = (LAS unsigned char*)lds;
    const int wave0 = __builtin_amdgcn_readfirstlane(threadIdx.x >> 6);
    volatile LAS unsigned* MISC = (volatile LAS unsigned*)(ldsl + MISC_OFF);
    unsigned char* ws = args.ws;
    gu32* ctl = (gu32*)(ws + WS_CTL);
    const float* x = args.in[0]; const float* w_in = args.in[1]; const float* pool_w = args.in[2]; const float* pool_scale = args.in[3];
    const float* rel_bias = args.in[4]; const float* w_out = args.in[5]; const float* ln1_g = args.in[6]; const float* ln1_b = args.in[7];
    const float* peer_wq = args.in[8]; const float* peer_sub = args.in[9]; const float* peer_u = args.in[10]; const float* peer_v = args.in[11];
    const float* ln2_g = args.in[12]; const float* ln2_b = args.in[13];
    float* out = args.out;
    bf16* PoolWT = (bf16*)(ws + WS_POOLWT); bf16* WoutT = (bf16*)(ws + WS_WOUTT); bf16* WqT = (bf16*)(ws + WS_WQT); bf16* WinT = (bf16*)(ws + WS_WINT);
    bf16* KIWI = (bf16*)(ws + WS_KIWI); unsigned* MASK = (unsigned*)(ws + WS_MASK); bf16* POOLED = (bf16*)(ws + WS_POOLED);
    bf16* XB = (bf16*)(ws + WS_XB); bf16* MIXIN = (bf16*)(ws + WS_MIXIN);
    bf16* PV = (bf16*)(ws + WS_PV); bf16* Qb = (bf16*)(ws + WS_Q); bf16* Kb = (bf16*)(ws + WS_K); bf16* Vb = (bf16*)(ws + WS_V); bf16* QI = (bf16*)(ws + WS_QI);
    float* STATS = (float*)(ws + WS_STATSP); float* CSUM = (float*)(ws + WS_CSUM); float* BVEC = (float*)(ws + WS_BVEC); float* CSP = (float*)(ws + WS_CSP); float* BVP = (float*)(ws + WS_BVP);
    bf16* HB = (bf16*)(ws + WS_HB); bf16* QP = (bf16*)(ws + WS_QP); unsigned char* U8 = ws + WS_U8; unsigned char* V8 = ws + WS_V8;
    int* EIDX = (int*)(ws + WS_EIDX); float* GATE = (float*)(ws + WS_GATE); float* ISU = (float*)(ws + WS_ISU); float* ISV = (float*)(ws + WS_ISV); bf16* SKB = (bf16*)(ws + WS_SKB);

    for (int u = threadIdx.x; u < (LDS_BYTES - LDSCTL_OFF) / 4; u += NTHREADS) ((LAS unsigned*)(ldsl + LDSCTL_OFF))[u] = 0u;
    __syncthreads();
    XcdBarrier bar = xcd_barrier_post((unsigned*)(ctl + CW_BAR), MISC + 8);

    { FRAME_INIT(); p0_first(F, x, w_in, XB, WinT); }
    xcd_barrier(bar);
    { FRAME_INIT(); const int ndef = F.G / 8, gG = F.G - ndef, c = (int)blockIdx.x;
      if (c >= gG) { p0_deferred(F, c - gG, ndef, pool_w, w_out, peer_wq, PoolWT, WoutT, WqT, ln1_g, ln1_b, CSP, BVP, peer_sub, SKB, peer_u, peer_v, U8, ISU, ISV); }
      else { pg8::Gemm g{XB, WinT, M_TOK, D_IN_PAD, 2048, 2048, 2048, 0, 20}; pg8::StaticOrder S; S.init(M_TOK, D_IN_PAD, gG, c);
        pg8::EpiProj E{PV, (size_t)M_TOK * 1024, KIWI};
        pg8::gemm_phase<pg8::EpiProj, pg8::StaticOrder, true, true>(F.lds + RING_OFF, g, S, E, F.tid); } }
    xcd_barrier(bar);
    { FRAME_INIT(); ln1_fold_reduce(F, CSP, BVP, CSUM, BVEC); }
    { int vcu0, G0; { FRAME_INIT(); vcu0 = F.vcu; G0 = F.G; }
      for (int base = vcu0; base < 256; base += G0) {
#pragma unroll 1
        for (int i = 0; i < 4; ++i) {
          if (i == (vcu0 & 3) && base == vcu0) { FRAME_INIT(); phase_pool_prep(F, PV, POOLED); }
          { FRAME_INIT(); indexer_unit(F, i, (i & 1) ? 255 - base : base, QI, KIWI, MASK); }
        } } }
    xcd_barrier(bar);
    for (int st = 0; st < 2; ++st) {
      bool gemm_now; { FRAME_INIT(); gemm_now = (st == 0) == ((F.vcu & 1) == 0); }
      if (gemm_now) { FRAME_INIT(); pg8::Gemm g{POOLED, PoolWT, M_TOK, 1024, 256, 1024, 256, 256, -1}; pg8::StaticOrder S; S.init(M_TOK, 1024, F.G, (int)blockIdx.x);
        pg8::EpiBf16S E{MIXIN, 2048, pool_scale};
        pg8::gemm_phase<pg8::EpiBf16S, pg8::StaticOrder, true, true>(F.lds + RING_OFF, g, S, E, F.tid); }
      else { FRAME_INIT(); phase_attn_fast(F, Qb, Kb, Vb, MASK, rel_bias, MIXIN); }
      __syncthreads();
    }
    xcd_barrier(bar);
    { FRAME_INIT(); pg8::Gemm g{MIXIN, WoutT, M_TOK, 2048, 2048, 2048, 2048, 0, -1}; pg8::StaticOrder S; S.init(M_TOK, 2048, F.G, (int)blockIdx.x);
      LAS float* lst = (LAS float*)(F.lds + LN1_L_STATS);
#pragma unroll
      for (int i = 0; i < 8; ++i) lst[F.tid + 512 * i] = 0.f;
      pg8::Unit u0, ui; const bool any = S.next(0, u0); bool same = true; int nun = any ? 1 : 0;
      for (int i = 1; S.next(i, ui); ++i) { same = same && (ui.pm == u0.pm); ++nun; }
      const bool fast = any && same && nun <= 2 && u0.pn < 4;
      __syncthreads();
      pg8::EpiResBf16St E{(bf16*)(ws + 392 * MiB), XB, 2048, ALPHA, fast ? lst : (LAS float*)nullptr, STATS};
      pg8::gemm_phase<pg8::EpiResBf16St, pg8::StaticOrder, true, true>(F.lds + RING_OFF, g, S, E, F.tid); }
    __syncthreads();
    { FRAME_INIT(); pg8::StaticOrder S; S.init(M_TOK, 2048, F.G, (int)blockIdx.x);
      pg8::Unit u0, ui; const bool any = S.next(0, u0); bool same = true; int nun = any ? 1 : 0;
      for (int i = 1; S.next(i, ui); ++i) { same = same && (ui.pm == u0.pm); ++nun; }
      if (any && same && nun <= 2 && u0.pn < 4) { LAS const float* lp = (LAS const float*)(F.lds + LN1_L_STATS) + F.tid; float v = 0.f;
#pragma unroll
          for (int i = 0; i < 8; ++i) v += lp[512 * i];
          STATS[(size_t)u0.pm * 2048 + (u0.pn & 3) * 512 + F.tid] = v; } }
    xcd_barrier(bar);
    { FRAME_INIT(); pg8::Gemm g{(const bf16*)(ws + 392 * MiB), WqT, M_TOK, 2048, 2048, 2048, 2048, 0, -1}; pg8::StaticOrder S; S.init(M_TOK, 2048, F.G, (int)blockIdx.x);
      pg8::EpiLNFold E{QP, 2048, STATS, CSUM, BVEC};
      pg8::gemm_phase<pg8::EpiLNFold, pg8::StaticOrder, true, true>(F.lds + RING_OFF, g, S, E, F.tid); }
    xcd_barrier(bar);
    { FRAME_INIT(); phase_peer_fast(F, out, (const bf16*)(ws + 392 * MiB), STATS, QP, SKB, EIDX, GATE, U8, ISU, ISV, ln2_g, ln2_b, ln1_g, ln1_b); }
}

extern "C" void kernel_launch(void* const* d_in, const int* in_sizes, int n_in, void* d_out, int out_size, void* d_ws, size_t ws_size, hipStream_t stream) {
    static int grid = 0;
    if (grid == 0) {
        if (n_in != 14 || out_size != M_TOK * D_MODEL || ws_size < WS_END) { fprintf(stderr, "kernel_launch: unexpected shapes (n_in %d out %d ws %zu)\n", n_in, out_size, ws_size); grid = -1; return; }
        int dev = 0, cus = 0, per_cu = 0;
        if (hipGetDevice(&dev) != hipSuccess || hipDeviceGetAttribute(&cus, hipDeviceAttributeMultiprocessorCount, dev) != hipSuccess) { grid = -1; return; }
        if (hipFuncSetAttribute((const void*)mega_fwd, hipFuncAttributeMaxDynamicSharedMemorySize, LDS_BYTES) != hipSuccess) { fprintf(stderr, "kernel_launch: hipFuncSetAttribute failed\n"); grid = -1; return; }
        if (hipOccupancyMaxActiveBlocksPerMultiprocessor(&per_cu, (const void*)mega_fwd, NTHREADS, LDS_BYTES) != hipSuccess || per_cu < 1) fprintf(stderr, "kernel_launch: occupancy query says %d\n", per_cu);
        (void)hipGetLastError();
        grid = cus;
    }
    if (grid < 0) return;
    if (hipMemsetAsync((char*)d_ws + WS_CTL, 0, CTL_ZERO_BYTES, stream) != hipSuccess) { fprintf(stderr, "kernel_launch: memset failed\n"); return; }
    Args a{};
    for (int i = 0; i < 14; ++i) a.in[i] = (const float*)d_in[i];
    a.out = (float*)d_out; a.ws = (unsigned char*)d_ws;
    hipLaunchKernelGGL(mega_fwd, dim3(grid), dim3(NTHREADS), LDS_BYTES, stream, a);
}
```
